# Optimizing an MI355X kernel written in HIP

```python
import jax, jax.numpy as jnp
from jax import lax
import numpy as np

D_MODEL = 1024
BATCH = 8
SEQ = 2048
DEPTH = 2
DEC_BATCH = 128
DEC_SEQ = 1
PAST_LEN = 8192
PAGE_SIZE = 128

N_A_LAYERS = DEPTH // 2
N_B_LAYERS = DEPTH - N_A_LAYERS
CHUNK = 128
A_WIDTH = 2 * D_MODEL
A_GROUPS = 8
A_GROUP_DIM = A_WIDTH // A_GROUPS
HEAD_DIM = 64
N_HEADS = D_MODEL // HEAD_DIM
N_KV_HEADS = 4
GQA_GROUP = N_HEADS // N_KV_HEADS
WINDOW = 128
Q_BLOCK = 128
ROT_DIM = HEAD_DIM // 4
ROPE_THETA = 500000.0
EPS = 1e-5
BUF_LEN = min(WINDOW, PAST_LEN)

kernel_name = "yoco_chunk_gmlp_swa_sink_step"


def rms_norm(x, g):
    xf = x.astype(jnp.float32)
    y = xf * lax.rsqrt(jnp.mean(xf * xf, axis=-1, keepdims=True) + EPS)
    return (y * g.astype(jnp.float32)).astype(x.dtype)


def rotary(x, start):
    L = x.shape[1]
    pos = (start + jnp.arange(L)).astype(jnp.float32)
    inv = ROPE_THETA ** (-jnp.arange(0, ROT_DIM, 2, dtype=jnp.float32) / ROT_DIM)
    ang = pos[:, None] * inv[None, :]
    cos = jnp.cos(ang)[None, :, None, :]
    sin = jnp.sin(ang)[None, :, None, :]
    xr = x[..., :ROT_DIM].astype(jnp.float32)
    x1, x2 = xr[..., :ROT_DIM // 2], xr[..., ROT_DIM // 2:]
    rot = jnp.concatenate([x1 * cos - x2 * sin, x2 * cos + x1 * sin], axis=-1).astype(x.dtype)
    return jnp.concatenate([rot, x[..., ROT_DIM:]], axis=-1)


def chunk_gmlp_mixer(h, norm_g, w_in, v_norm_g, w_s, b_s, w_out):
    B, L, _ = h.shape
    xn = rms_norm(h, norm_g)
    proj = jnp.einsum('bld,de->ble', xn, w_in)
    u, v, gate = jnp.split(proj, 3, axis=-1)
    v = rms_norm(v, v_norm_g)
    cl = CHUNK if L >= CHUNK else L
    n = -(-L // cl)
    pad = n * cl - L
    vp = jnp.pad(v, ((0, 0), (0, pad), (0, 0))).reshape(B, n, cl, A_GROUPS, A_GROUP_DIM)
    causal = jnp.tril(jnp.ones((cl, cl), dtype=bool))
    ws = jnp.where(causal[None], w_s[:, :cl, :cl], 0)
    z = jnp.einsum('gij,bnjgc->bnigc', ws, vp) + b_s[:, :cl].T[None, None, :, :, None]
    z = z.reshape(B, n * cl, A_WIDTH)[:, :L]
    y = u * z * jax.nn.silu(gate)
    return jnp.einsum('ble,ed->bld', y, w_out), v


def shared_kv(h, kv_norm, w_kv, start):
    B, L, _ = h.shape
    xn = rms_norm(h, kv_norm)
    kv = jnp.einsum('bld,de->ble', xn, w_kv)
    k, v = jnp.split(kv, 2, axis=-1)
    k = rotary(k.reshape(B, L, N_KV_HEADS, HEAD_DIM), start)
    return k, v.reshape(B, L, N_KV_HEADS, HEAD_DIM)


def sliding_window_attention(q, k_ext, v_ext, sinks, start):
    B, L = q.shape[:2]
    qb = Q_BLOCK if L >= Q_BLOCK else L
    n = -(-L // qb)
    pad = n * qb - L
    q = jnp.pad(q, ((0, 0), (0, pad), (0, 0), (0, 0))).reshape(B, n, qb, N_KV_HEADS, GQA_GROUP, HEAD_DIM)
    k_ext = jnp.pad(k_ext, ((0, 0), (0, pad), (0, 0), (0, 0)))
    v_ext = jnp.pad(v_ext, ((0, 0), (0, pad), (0, 0), (0, 0)))
    span = WINDOW + qb
    idx = (jnp.arange(n) * qb)[:, None] + jnp.arange(span)[None, :]
    kb = k_ext[:, idx]
    vb = v_ext[:, idx]
    s = jnp.einsum('bnqkgd,bnskd->bnkgqs', q, kb, preferred_element_type=jnp.float32) * (HEAD_DIM ** -0.5)
    i = jnp.arange(qb)[:, None]
    j = jnp.arange(span)[None, :]
    band = (j >= i) & (j <= WINDOW + i)
    key_pos = start - WINDOW + idx
    valid = band[None] & (key_pos >= 0)[:, None, :]
    s = jnp.where(valid[None, :, None, None], s, -jnp.inf)
    sink = jnp.broadcast_to(sinks.astype(jnp.float32).reshape(1, 1, N_KV_HEADS, GQA_GROUP, 1, 1), s.shape[:-1] + (1,))
    p = jax.nn.softmax(jnp.concatenate([s, sink], axis=-1), axis=-1)[..., :-1]
    o = jnp.einsum('bnkgqs,bnskd->bnqkgd', p.astype(v_ext.dtype), vb)
    return o.reshape(B, n * qb, N_HEADS * HEAD_DIM)[:, :L]


def swa_mixer(h, k_ext, v_ext, start, norm_g, w_in, sinks, w_out):
    B, L, _ = h.shape
    xn = rms_norm(h, norm_g)
    proj = jnp.einsum('bld,de->ble', xn, w_in)
    q, gate = jnp.split(proj, 2, axis=-1)
    q = rotary(q.reshape(B, L, N_HEADS, HEAD_DIM), start)
    o = sliding_window_attention(q, k_ext, v_ext, sinks, start)
    return jnp.einsum('ble,ed->bld', o * jax.nn.silu(gate), w_out)


def trunk(x, start, k_past, v_past, norm_a, w_in_a, v_norm_a, w_s_a, b_s_a, w_out_a,
          kv_norm, w_kv, norm_b, w_in_b, sinks_b, w_out_b, final_norm):
    B, L, _ = x.shape
    front = WINDOW - k_past.shape[1]
    h = x
    a_rows = []
    k_ext = None
    v_ext = None
    for layer in range(DEPTH):
        if layer < N_A_LAYERS:
            out, v_rows = chunk_gmlp_mixer(h, norm_a[layer], w_in_a[layer], v_norm_a[layer],
                                           w_s_a[layer], b_s_a[layer], w_out_a[layer])
            h = h + out
            a_rows.append(v_rows)
        else:
            if layer == N_A_LAYERS:
                k_new, v_new = shared_kv(h, kv_norm, w_kv, start)
                k_ext = jnp.concatenate([jnp.pad(k_past, ((0, 0), (front, 0), (0, 0), (0, 0))).astype(k_new.dtype), k_new], axis=1)
                v_ext = jnp.concatenate([jnp.pad(v_past, ((0, 0), (front, 0), (0, 0), (0, 0))).astype(v_new.dtype), v_new], axis=1)
            lb = layer - N_A_LAYERS
            h = h + swa_mixer(h, k_ext, v_ext, start, norm_b[lb], w_in_b[lb], sinks_b[lb], w_out_b[lb])
    y = rms_norm(h, final_norm)
    keep = min(WINDOW, start + L)
    return y, k_ext[:, -keep:], v_ext[:, -keep:], jnp.stack(a_rows)


def setup_inputs(seed: int = 0) -> dict:
    key = jax.random.key(seed)
    ks = jax.random.split(key, 20)
    f32 = jnp.float32
    nrm = lambda k, shape, scale: jax.random.normal(k, shape, f32) * scale
    return {
        'x_prompt': nrm(ks[0], (BATCH, SEQ, D_MODEL), 1.0),
        'x_sample': nrm(ks[1], (DEC_BATCH, DEC_SEQ, D_MODEL), 1.0),
        'cache_k': nrm(ks[2], (DEC_BATCH, BUF_LEN, N_KV_HEADS, HEAD_DIM), 1.0),
        'cache_v': nrm(ks[3], (DEC_BATCH, BUF_LEN, N_KV_HEADS, HEAD_DIM), 1.0),
        'norm_a': 1.0 + nrm(ks[4], (N_A_LAYERS, D_MODEL), 0.1),
        'w_in_a': nrm(ks[5], (N_A_LAYERS, D_MODEL, 3 * A_WIDTH), D_MODEL ** -0.5),
        'v_norm_a': 1.0 + nrm(ks[6], (N_A_LAYERS, A_WIDTH), 0.1),
        'w_s_a': nrm(ks[7], (N_A_LAYERS, A_GROUPS, CHUNK, CHUNK), CHUNK ** -0.5),
        'b_s_a': 1.0 + nrm(ks[8], (N_A_LAYERS, A_GROUPS, CHUNK), 0.1),
        'w_out_a': nrm(ks[9], (N_A_LAYERS, A_WIDTH, D_MODEL), A_WIDTH ** -0.5),
        'kv_norm': 1.0 + nrm(ks[10], (D_MODEL,), 0.1),
        'w_kv': nrm(ks[11], (D_MODEL, 2 * N_KV_HEADS * HEAD_DIM), D_MODEL ** -0.5),
        'norm_b': 1.0 + nrm(ks[12], (N_B_LAYERS, D_MODEL), 0.1),
        'w_in_b': nrm(ks[13], (N_B_LAYERS, D_MODEL, 2 * N_HEADS * HEAD_DIM), D_MODEL ** -0.5),
        'sinks_b': nrm(ks[14], (N_B_LAYERS, N_HEADS), 1.0),
        'w_out_b': nrm(ks[15], (N_B_LAYERS, N_HEADS * HEAD_DIM, D_MODEL), (N_HEADS * HEAD_DIM) ** -0.5),
        'final_norm': 1.0 + nrm(ks[16], (D_MODEL,), 0.1),
    }


def reference(x_prompt, x_sample, cache_k, cache_v, norm_a, w_in_a, v_norm_a, w_s_a, b_s_a, w_out_a,
              kv_norm, w_kv, norm_b, w_in_b, sinks_b, w_out_b, final_norm):
    weights = (norm_a, w_in_a, v_norm_a, w_s_a, b_s_a, w_out_a, kv_norm, w_kv, norm_b, w_in_b, sinks_b, w_out_b, final_norm)
    empty = jnp.zeros((x_prompt.shape[0], 0, N_KV_HEADS, HEAD_DIM), x_prompt.dtype)
    y_prompt, new_k_prompt, new_v_prompt, _ = trunk(x_prompt, 0, empty, empty, *weights)
    y_sample, new_k_sample, new_v_sample, new_av_sample = trunk(x_sample, PAST_LEN, cache_k, cache_v, *weights)
    return (y_prompt, y_sample, new_k_prompt, new_v_prompt, new_k_sample, new_v_sample, new_av_sample)
```

```cpp
#include <hip/hip_runtime.h>
#include <hip/hip_cooperative_groups.h>
#include <cstdio>
#include <cstdint>
namespace cg = cooperative_groups;
namespace pg8 {
#define PG8_LAS __attribute__((address_space(3)))
typedef unsigned short bf16_t;
typedef short bf16x8 __attribute__((ext_vector_type(8)));
typedef float f32x4 __attribute__((ext_vector_type(4)));
typedef unsigned u32x4 __attribute__((ext_vector_type(4)));
constexpr int BM = 256, BK = 64, HALF = 128, HTB = HALF * BK * 2  , STAGE_BYTES = 8 * HTB, NXCD = 8, WGM = 8;

__host__ __device__ __forceinline__ int lds_byte(int r, int c) { const int st = (r >> 4) * 2 + (c >> 5), rr = r & 15, cc = c & 31, ob = rr * 64 + cc * 2; return st * 1024 + (ob ^ (((ob >> 9) & 1) << 5)); }
__host__ __device__ __forceinline__ void stage_rc(int b, int& R, int& C) { const int st = b / 1024, sb = b % 1024, swz = sb ^ (((sb >> 9) & 1) << 5); R = (st >> 1) * 16 + swz / 64; C = (st & 1) * 32 + (swz % 64) / 2; }
__host__ __device__ __forceinline__ int perm32(int rho) { const int n = rho >> 4, i = rho & 15; return 8 * (i >> 2) + 4 * n + (i & 3); }

struct Unit { int pm, pn; };
struct Gemm { const bf16_t* A; const bf16_t* Bt; int M, N, K; };

struct StaticOrder {
    int nM, nN, nwg, G, c;
    __host__ __device__ void init(int M, int N, int G_, int c_) { nM = M / BM; nN = N / BM; nwg = nM * nN; G = G_; c = c_; }
    __host__ __device__ bool next(int i, Unit& u) const {
        const long L = (long)i * G + c; if (L >= nwg) return false;
        int wgid = (int)L; { const int q = nwg / NXCD, r = nwg % NXCD, xcd = wgid % NXCD, off = wgid / NXCD; wgid = (xcd < r ? xcd * (q + 1) : r * (q + 1) + (xcd - r) * q) + off; }
        const int nig = WGM * nN, gid = wgid / nig, fm = gid * WGM, gsz = (nM - fm) < WGM ? (nM - fm) : WGM;
        u.pm = fm + ((wgid % nig) % gsz); u.pn = (wgid % nig) / gsz; return true;
    }
    __device__ __forceinline__ void a_ready(const Unit&) const {}
    __device__ __forceinline__ void done(const Unit&) const {}
};
__device__ __forceinline__ unsigned cvt_pk_bf16(float lo, float hi) { unsigned r; asm volatile("v_cvt_pk_bf16_f32 %0, %1, %2" : "=v"(r) : "v"(lo), "v"(hi)); return r; }
template <class Epi, class Sched, bool ALIGN_EPI = false, bool SP2 = false>
__device__ __forceinline__ void gemm_phase(PG8_LAS unsigned char* lds, const Gemm g, const Sched& S, const Epi& E) {
    const int tid = threadIdx.x, wid = __builtin_amdgcn_readfirstlane(tid >> 6), lane = tid & 63, wr = wid >> 2, wc = wid & 3, fr = lane & 15, fq = lane >> 4;
    const int K = g.K, nt = K / BK;
    unsigned voffA[2], voffB[2];
#pragma unroll
    for (int i = 0; i < 2; ++i) { int R, C; stage_rc(tid * 16 + i * 8192, R, C); const int Rb = Epi::PERM ? ((R & ~31) + perm32(R & 31)) : R;
        voffA[i] = (unsigned)(R * K + C) * 2u; voffB[i] = (unsigned)(Rb * K + C) * 2u; }
    const size_t kstep = (size_t)(BK * 2);
    const size_t hstep = (size_t)HALF * K * 2;
    const size_t tstep = 2 * hstep;
    const unsigned ldsw = (unsigned)wid * 1024u;
    const int aoff = lds_byte(wr * 64 + fr, fq * 8), boff = lds_byte(wc * 32 + fr, fq * 8);
#define PG8_SA(b, h) (((b) * 2 + (h)) * HTB)
#define PG8_SB(b, h) ((4 + (b) * 2 + (h)) * HTB)
#define PG8_STAGE(bufoff, gbase, voff) do { _Pragma("unroll") for (int _i = 0; _i < 2; ++_i) \
        __builtin_amdgcn_global_load_lds((const unsigned*)((const char*)(gbase) + (voff)[_i]), (PG8_LAS unsigned*)(lds + (bufoff) + ldsw + _i * 8192), 16, 0, 0); } while (0)
#define PG8_LDA(dst, b, h) do { _Pragma("unroll") for (int m = 0; m < 4; ++m) _Pragma("unroll") for (int k = 0; k < 2; ++k) dst[m][k] = *(const PG8_LAS bf16x8*)(lds + PG8_SA(b, h) + aoff + m * 2048 + k * 1024); } while (0)
#define PG8_LDB(dst, b, h) do { _Pragma("unroll") for (int n = 0; n < 2; ++n) _Pragma("unroll") for (int k = 0; k < 2; ++k) dst[n][k] = *(const PG8_LAS bf16x8*)(lds + PG8_SB(b, h) + boff + n * 2048 + k * 1024); } while (0)
#define PG8_MMA(ai, bj, At, Bt) do { __builtin_amdgcn_s_setprio(1); _Pragma("unroll") for (int m = 0; m < 4; ++m) _Pragma("unroll") for (int n = 0; n < 2; ++n) _Pragma("unroll") for (int k = 0; k < 2; ++k) \
        acc[ai][bj][m][n] = __builtin_amdgcn_mfma_f32_16x16x32_bf16(Bt[n][k], At[m][k], acc[ai][bj][m][n], 0, 0, 0); __builtin_amdgcn_s_setprio(0); } while (0)
#define PG8_WAIT_V(n) asm volatile("s_waitcnt vmcnt(" #n ")" ::: "memory")
#define PG8_WAIT_L(n) asm volatile("s_waitcnt lgkmcnt(" #n ")" ::: "memory")
#define PG8_BAR __builtin_amdgcn_s_barrier()
#define PG8_SCHED __builtin_amdgcn_sched_barrier(0)
    Unit cur, nxt; int ui = 0;
    if (!S.next(0, cur)) return;
    f32x4 acc[2][2][4][2];
#pragma unroll
    for (int a = 0; a < 2; ++a)
#pragma unroll
        for (int b = 0; b < 2; ++b)
#pragma unroll
            for (int m = 0; m < 4; ++m)
#pragma unroll
                for (int n = 0; n < 2; ++n) acc[a][b][m][n] = (f32x4){0.f, 0.f, 0.f, 0.f};
    bf16x8 At[4][2], B0[2][2], B1[2][2];
    const char* cA = (const char*)g.A + (size_t)cur.pm * tstep; const char* cB = (const char*)g.Bt + (size_t)cur.pn * tstep;
    S.a_ready(cur);
    if constexpr (SP2) {
        PG8_STAGE(PG8_SB(0, 0), cB, voffB); PG8_STAGE(PG8_SB(0, 1), cB + hstep, voffB); PG8_STAGE(PG8_SA(0, 0), cA, voffA); PG8_STAGE(PG8_SA(0, 1), cA + hstep, voffA);
        if (wr == 1) PG8_BAR;
        PG8_WAIT_V(2); PG8_BAR;
        PG8_STAGE(PG8_SB(1, 0), cB + kstep, voffB); PG8_STAGE(PG8_SA(1, 0), cA + kstep, voffA); PG8_STAGE(PG8_SB(1, 1), cB + hstep + kstep, voffB);
        PG8_WAIT_V(6); PG8_BAR;
    } else {
        PG8_STAGE(PG8_SB(0, 0), cB, voffB); PG8_STAGE(PG8_SA(0, 0), cA, voffA); PG8_STAGE(PG8_SB(0, 1), cB + hstep, voffB); PG8_STAGE(PG8_SA(0, 1), cA + hstep, voffA);
        if (wr == 1) PG8_BAR;
        PG8_WAIT_V(4); PG8_BAR;
        PG8_STAGE(PG8_SB(1, 0), cB + kstep, voffB); PG8_STAGE(PG8_SA(1, 0), cA + kstep, voffA); PG8_STAGE(PG8_SB(1, 1), cB + hstep + kstep, voffB);
        PG8_WAIT_V(6); PG8_BAR;
    }
    for (;;) {
        const bool has_next = S.next(ui + 1, nxt);
        const char* nA = has_next ? (const char*)g.A + (size_t)nxt.pm * tstep : cA; const char* nB = has_next ? (const char*)g.Bt + (size_t)nxt.pn * tstep : cB;
        for (int t = 0; t < nt; t += 2) {
            const bool last = (t == nt - 2);
            const char* a1 = cA + (size_t)(t + 1) * kstep;
            const char* a2 = last ? nA : cA + (size_t)(t + 2) * kstep; const char* b2 = last ? nB : cB + (size_t)(t + 2) * kstep;
            const char* a3 = a2 + kstep; const char* b3 = b2 + kstep;
            if (last && has_next) S.a_ready(nxt);
            if constexpr (SP2) {
            PG8_LDB(B0, 0, 0); PG8_LDB(B1, 0, 1); PG8_SCHED; PG8_LDA(At, 0, 0); PG8_STAGE(PG8_SA(1, 1), a1 + hstep, voffA);
            PG8_WAIT_V(8); PG8_WAIT_L(0); PG8_BAR; PG8_MMA(0, 0, At, B0); PG8_MMA(0, 1, At, B1); PG8_BAR; PG8_SCHED;
            PG8_LDA(At, 0, 1); PG8_STAGE(PG8_SB(0, 0), b2, voffB); PG8_STAGE(PG8_SB(0, 1), b2 + hstep, voffB); PG8_STAGE(PG8_SA(0, 0), a2, voffA);
            PG8_WAIT_V(8); PG8_WAIT_L(0); PG8_BAR; PG8_MMA(1, 0, At, B0); PG8_MMA(1, 1, At, B1); PG8_BAR; PG8_SCHED;
            PG8_LDB(B0, 1, 0); PG8_LDB(B1, 1, 1); PG8_SCHED; PG8_LDA(At, 1, 0); PG8_STAGE(PG8_SA(0, 1), a2 + hstep, voffA);
            PG8_WAIT_V(8); PG8_WAIT_L(0); PG8_BAR; PG8_MMA(0, 0, At, B0); PG8_MMA(0, 1, At, B1); PG8_BAR; PG8_SCHED;
            PG8_LDA(At, 1, 1); PG8_STAGE(PG8_SB(1, 0), b3, voffB); PG8_STAGE(PG8_SB(1, 1), b3 + hstep, voffB); PG8_STAGE(PG8_SA(1, 0), a3, voffA);
            PG8_WAIT_V(8); PG8_WAIT_L(0); PG8_BAR; PG8_MMA(1, 0, At, B0); PG8_MMA(1, 1, At, B1); PG8_BAR; PG8_SCHED;
            } else {
            PG8_LDB(B0, 0, 0); PG8_SCHED; PG8_LDA(At, 0, 0); PG8_STAGE(PG8_SA(1, 1), a1 + hstep, voffA);
            PG8_WAIT_L(8); PG8_BAR; PG8_WAIT_L(0); PG8_MMA(0, 0, At, B0); PG8_BAR; PG8_SCHED;
            PG8_LDB(B1, 0, 1); PG8_STAGE(PG8_SB(0, 0), b2, voffB);
            PG8_BAR; PG8_WAIT_L(0); PG8_MMA(0, 1, At, B1); PG8_BAR;
            PG8_LDA(At, 0, 1); PG8_STAGE(PG8_SA(0, 0), a2, voffA);
            PG8_BAR; PG8_WAIT_L(0); PG8_MMA(1, 0, At, B0); PG8_BAR; PG8_SCHED;
            PG8_STAGE(PG8_SB(0, 1), b2 + hstep, voffB);
            PG8_WAIT_V(6); PG8_BAR; PG8_MMA(1, 1, At, B1); PG8_BAR;
            PG8_LDB(B0, 1, 0); PG8_SCHED; PG8_LDA(At, 1, 0); PG8_STAGE(PG8_SA(0, 1), a2 + hstep, voffA);
            PG8_WAIT_L(8); PG8_BAR; PG8_WAIT_L(0); PG8_MMA(0, 0, At, B0); PG8_BAR; PG8_SCHED;
            PG8_LDB(B1, 1, 1); PG8_STAGE(PG8_SB(1, 0), b3, voffB);
            PG8_BAR; PG8_WAIT_L(0); PG8_MMA(0, 1, At, B1); PG8_BAR;
            PG8_LDA(At, 1, 1); PG8_STAGE(PG8_SA(1, 0), a3, voffA);
            PG8_BAR; PG8_WAIT_L(0); PG8_MMA(1, 0, At, B0); PG8_BAR; PG8_SCHED;
            PG8_STAGE(PG8_SB(1, 1), b3 + hstep, voffB);
            PG8_WAIT_V(6); PG8_BAR; PG8_MMA(1, 1, At, B1); PG8_BAR;
            }
        }
        if constexpr (ALIGN_EPI) { if (wr == 0) PG8_BAR; }
        if constexpr (!Epi::AFTER_DRAIN) { E(acc, cur, wr, wc, fr, fq); S.done(cur); }
        if (!has_next) break;
#pragma unroll
        for (int a = 0; a < 2; ++a)
#pragma unroll
            for (int b = 0; b < 2; ++b)
#pragma unroll
                for (int m = 0; m < 4; ++m)
#pragma unroll
                    for (int n = 0; n < 2; ++n) acc[a][b][m][n] = (f32x4){0.f, 0.f, 0.f, 0.f};
        cur = nxt; cA = nA; cB = nB; ++ui;
        if constexpr (ALIGN_EPI) { if (wr == 1) PG8_BAR; }
    }
    PG8_WAIT_V(0);
    if constexpr (!ALIGN_EPI) { if (wr == 0) PG8_BAR; }
    PG8_BAR;
    if constexpr (Epi::AFTER_DRAIN) { E.fused(acc, cur, wr, wc, fr, fq, lds, wid, lane); S.done(cur); }
#undef PG8_SA
#undef PG8_SB
#undef PG8_STAGE
#undef PG8_LDA
#undef PG8_LDB
#undef PG8_MMA
#undef PG8_WAIT_V
#undef PG8_WAIT_L
#undef PG8_BAR
#undef PG8_SCHED
}
}

#define LAS __attribute__((address_space(3)))
using pg8::bf16_t; using pg8::bf16x8; using pg8::f32x4; using pg8::u32x4; using pg8::Unit;
typedef unsigned u32x2 __attribute__((ext_vector_type(2)));
constexpr int DM = 1024, TP = 16384, TS = 128, TT = TP + TS, AW = 2048, NWV = 8;
constexpr float EPS = 1e-5f;
constexpr size_t MiB = 1u << 20;
constexpr size_t WS_W1 = 0, WS_W2 = 12 * MiB, WS_W3 = 16 * MiB, WS_W4 = 21 * MiB, WS_SMALL = 23 * MiB, WS_UVGS = 24 * MiB, WS_KVQGS = 27 * MiB,
                 WS_XN = 29 * MiB  , WS_VT = 62 * MiB  , WS_Y = 126 * MiB  , WS_END = 191 * MiB;
constexpr size_t OUT_YS = (size_t)TP * DM, OUT_KP = OUT_YS + (size_t)TS * DM, OUT_VP = OUT_KP + 262144, OUT_KS = OUT_VP + 262144, OUT_VS = OUT_KS + 4194304, OUT_AV = OUT_VS + 4194304;

__device__ __forceinline__ unsigned pk2(float a, float b) { return pg8::cvt_pk_bf16(a, b); }
__device__ __forceinline__ float bf2f(unsigned short h) { return __uint_as_float(((unsigned)h) << 16); }
__device__ __forceinline__ float silu(float x) { return x / (1.0f + __expf(-x)); }
__device__ __forceinline__ float wave_sum(float v) {
#pragma unroll
    for (int o = 1; o < 64; o <<= 1) v += __shfl_xor(v, o);
    return v;
}
__device__ __forceinline__ float wave_max(float v) {
#pragma unroll
    for (int o = 1; o < 64; o <<= 1) v = fmaxf(v, __shfl_xor(v, o));
    return v;
}
__device__ __forceinline__ u32x4 pack8(const f32x4 a, const f32x4 b) { u32x4 w; w.x = pk2(a[0], a[1]); w.y = pk2(a[2], a[3]); w.z = pk2(b[0], b[1]); w.w = pk2(b[2], b[3]); return w; }
#define LDS_WAIT() asm volatile("s_waitcnt lgkmcnt(0)" ::: "memory")

struct Params {
    const float *x_prompt, *x_sample, *cache_k, *cache_v, *norm_a, *w_in_a, *v_norm_a, *w_s_a, *b_s_a, *w_out_a, *kv_norm, *w_kv, *norm_b, *w_in_b, *sinks_b, *w_out_b, *final_norm;
    float* out; unsigned char* ws;
};
typedef const __attribute__((address_space(4))) Params* ArgP;

struct EpiVT {
    static constexpr bool PERM = true, AFTER_DRAIN = false;
    bf16_t* VT; float* vsq;
    __device__ __forceinline__ void operator()(const f32x4 (&acc)[2][2][4][2], const Unit& u, int wr_, int wc_, int fr_, int fq_) const {
        int fr = fr_, fq = fq_, wr = wr_, wc = wc_; asm volatile("" : "+v"(fr), "+v"(fq), "+s"(wr), "+s"(wc));
        const int t0 = u.pn * 256 + wc * 32 + 8 * fq;
        float cs[2][8];
#pragma unroll
        for (int bj = 0; bj < 2; ++bj)
#pragma unroll
            for (int j = 0; j < 8; ++j) cs[bj][j] = 0.f;
#pragma unroll
        for (int ai = 0; ai < 2; ++ai)
#pragma unroll
            for (int m = 0; m < 4; ++m) {
                const int c = u.pm * 256 + ai * 128 + wr * 64 + m * 16 + fr;
#pragma unroll
                for (int bj = 0; bj < 2; ++bj) {
                    const f32x4 v0 = acc[ai][bj][m][0], v1 = acc[ai][bj][m][1];
                    *(u32x4*)(VT + (size_t)c * TP + t0 + 128 * bj) = pack8(v0, v1);
#pragma unroll
                    for (int e = 0; e < 4; ++e) { cs[bj][e] += v0[e] * v0[e]; cs[bj][4 + e] += v1[e] * v1[e]; }
                }
            }
#pragma unroll
        for (int bj = 0; bj < 2; ++bj)
#pragma unroll
            for (int j = 0; j < 8; ++j) {
                float s = cs[bj][j];
                s += __shfl_xor(s, 1); s += __shfl_xor(s, 2); s += __shfl_xor(s, 4); s += __shfl_xor(s, 8);
                if (fr == 0) unsafeAtomicAdd(vsq + t0 + 128 * bj + j, s);
            }
    }
};

struct EpiUG {
    static constexpr bool PERM = true, AFTER_DRAIN = false;
    const bf16_t* VT; const float* vsq; const float* w_s; const float* b_s; const float* gv; bf16_t* Y;
    __device__ __forceinline__ void operator()(const f32x4 (&acc)[2][2][4][2], const Unit& u, int wr_, int wc_, int fr_, int fq_) const {
        int fr = fr_, fq = fq_, wr = wr_, wc = wc_; asm volatile("" : "+v"(fr), "+v"(fq), "+s"(wr), "+s"(wc));
        const int g = u.pn >> 1, cb = 128 * u.pn + 32 * wc;
        const int chA0 = cb + 8 * (fr >> 2) + (fr & 3);
        const int chL = cb + 8 * fq;
        const f32x4 gv0 = *(const f32x4*)(gv + chL), gv1 = *(const f32x4*)(gv + chL + 4);
#pragma unroll
        for (int ai = 0; ai < 2; ++ai) {
            const int tok0 = (2 * u.pm + ai) * 128;
            const bf16_t* vbase = VT + (size_t)chA0 * TP + tok0 + 8 * fq;
            const float* qbase = vsq + tok0 + 8 * fq;
#pragma unroll
            for (int m = 0; m < 4; ++m) {
                const int i = 64 * wr + 16 * m + fr, kmax = (64 * wr + 16 * m + 15) >> 5;
                f32x4 z0 = {0.f, 0.f, 0.f, 0.f}, z1 = {0.f, 0.f, 0.f, 0.f};
                const float* wrow = w_s + ((size_t)g * 128 + i) * 128 + 8 * fq;
#pragma unroll
                for (int kk = 0; kk < 4; ++kk) {
                    if (kk <= kmax) {
                        const f32x4 w0 = *(const f32x4*)(wrow + 32 * kk), w1 = *(const f32x4*)(wrow + 32 * kk + 4);
                        const f32x4 q0 = *(const f32x4*)(qbase + 32 * kk), q1 = *(const f32x4*)(qbase + 32 * kk + 4);
                        const bf16x8 va0 = *(const bf16x8*)(vbase + 32 * kk), va1 = *(const bf16x8*)(vbase + (size_t)4 * TP + 32 * kk);
                        const int dj = i - (32 * kk + 8 * fq);
                        f32x4 t0, t1;
#pragma unroll
                        for (int e = 0; e < 4; ++e) {
                            const float a0 = w0[e] * rsqrtf(q0[e] * (1.0f / AW) + EPS), a1 = w1[e] * rsqrtf(q1[e] * (1.0f / AW) + EPS);
                            t0[e] = __int_as_float(__float_as_int(a0) & ~((dj - e) >> 31));
                            t1[e] = __int_as_float(__float_as_int(a1) & ~((dj - 4 - e) >> 31)); }
                        const bf16x8 bfv = __builtin_bit_cast(bf16x8, pack8(t0, t1));
                        z0 = __builtin_amdgcn_mfma_f32_16x16x32_bf16(va0, bfv, z0, 0, 0, 0);
                        z1 = __builtin_amdgcn_mfma_f32_16x16x32_bf16(va1, bfv, z1, 0, 0, 0);
                    }
                }
                const float bias = b_s[g * 128 + i];
                const f32x4 u0 = acc[ai][0][m][0], u1 = acc[ai][0][m][1], g0 = acc[ai][1][m][0], g1 = acc[ai][1][m][1];
                f32x4 y0, y1;
#pragma unroll
                for (int e = 0; e < 4; ++e) { y0[e] = u0[e] * (gv0[e] * z0[e] + bias) * silu(g0[e]); y1[e] = u1[e] * (gv1[e] * z1[e] + bias) * silu(g1[e]); }
                *(u32x4*)(Y + (size_t)(tok0 + i) * AW + chL) = pack8(y0, y1);
                asm volatile("" ::: "memory");
            }
        }
    }
};

template <bool WITH_BF16> struct EpiRes {
    static constexpr bool PERM = true, AFTER_DRAIN = false;
    const float* base; float* H; bf16_t* Hb; float* sq;
    __device__ __forceinline__ void operator()(const f32x4 (&acc)[2][2][4][2], const Unit& u, int wr_, int wc_, int fr_, int fq_) const {
        int fr = fr_, fq = fq_, wr = wr_, wc = wc_; asm volatile("" : "+v"(fr), "+v"(fq), "+s"(wr), "+s"(wc));
        const int col0 = u.pn * 256 + wc * 32 + 8 * fq;
#pragma unroll
        for (int ai = 0; ai < 2; ++ai)
#pragma unroll
            for (int m = 0; m < 4; ++m) {
                const int row = u.pm * 256 + ai * 128 + wr * 64 + m * 16 + fr; float s = 0.f;
#pragma unroll
                for (int bj = 0; bj < 2; ++bj) {
                    const size_t off = (size_t)row * DM + col0 + 128 * bj;
                    const f32x4 h0 = acc[ai][bj][m][0] + *(const f32x4*)(base + off), h1 = acc[ai][bj][m][1] + *(const f32x4*)(base + off + 4);
                    *(f32x4*)(H + off) = h0; *(f32x4*)(H + off + 4) = h1;
                    if (WITH_BF16) *(u32x4*)(Hb + off) = pack8(h0, h1);
#pragma unroll
                    for (int e = 0; e < 4; ++e) s += h0[e] * h0[e] + h1[e] * h1[e];
                }
                s += __shfl_xor(s, 16); s += __shfl_xor(s, 32);
                if (fq == 0) unsafeAtomicAdd(sq + row, s);
            }
    }
};

struct Epi3 {
    static constexpr bool PERM = true, AFTER_DRAIN = false;
    const float* hsq; const float* rope; bf16_t *Kb, *Vb, *Qb, *Gb; float *outk, *outv;
    __device__ __forceinline__ void operator()(const f32x4 (&acc)[2][2][4][2], const Unit& u, int wr_, int wc_, int fr_, int fq_) const {
        int fr = fr_, fq = fq_, wr = wr_, wc = wc_; asm volatile("" : "+v"(fr), "+v"(fq), "+s"(wr), "+s"(wc));
        const int pn = u.pn; const bool rot = (pn == 0 || (pn >= 2 && pn < 6)) && ((wc & 1) == 0);
#pragma unroll
        for (int ai = 0; ai < 2; ++ai)
#pragma unroll
            for (int m = 0; m < 4; ++m) {
                const int row = u.pm * 256 + ai * 128 + wr * 64 + m * 16 + fr, pos = row & 2047, b = row >> 11;
                const float rs = rsqrtf(hsq[row] * (1.0f / DM) + EPS);
                const float* rp = rope + pos * 16;
#pragma unroll
                for (int bj = 0; bj < 2; ++bj) {
                    f32x4 v0 = acc[ai][bj][m][0] * rs, v1 = acc[ai][bj][m][1] * rs;
                    const int cw = 128 * bj + 32 * wc + 8 * fq;
                    if (rot) {
                        const f32x4 c0 = *(const f32x4*)(rp), c1 = *(const f32x4*)(rp + 4), s0 = *(const f32x4*)(rp + 8), s1 = *(const f32x4*)(rp + 12);
#pragma unroll
                        for (int e = 0; e < 4; ++e) {
                            const float p0 = __shfl_xor(v0[e], 16), p1 = __shfl_xor(v1[e], 16);
                            const float a0 = fq == 0 ? v0[e] * c0[e] - p0 * s0[e] : v0[e] * c0[e] + p0 * s0[e];
                            const float a1 = fq == 0 ? v1[e] * c1[e] - p1 * s1[e] : v1[e] * c1[e] + p1 * s1[e];
                            if (fq < 2) { v0[e] = a0; v1[e] = a1; }
                        }
                    }
                    if (pn == 0) {
                        *(u32x4*)(Kb + (size_t)row * 256 + cw) = pack8(v0, v1);
                        if (pos >= 1920) { float* o = outk + ((size_t)(b * 128 + pos - 1920)) * 256 + cw; *(f32x4*)o = v0; *(f32x4*)(o + 4) = v1; }
                    } else if (pn == 1) {
                        *(u32x4*)(Vb + (size_t)row * 256 + cw) = pack8(v0, v1);
                        if (pos >= 1920) { float* o = outv + ((size_t)(b * 128 + pos - 1920)) * 256 + cw; *(f32x4*)o = v0; *(f32x4*)(o + 4) = v1; }
                    } else if (pn < 6) {
                        *(u32x4*)(Qb + (size_t)row * DM + 256 * (pn - 2) + cw) = pack8(v0 * 0.125f, v1 * 0.125f);
                    } else {
                        f32x4 g0, g1;
#pragma unroll
                        for (int e = 0; e < 4; ++e) { g0[e] = silu(v0[e]); g1[e] = silu(v1[e]); }
                        *(u32x4*)(Gb + (size_t)row * DM + 256 * (pn - 6) + cw) = pack8(g0, g1);
                    }
                }
            }
    }
};

template <class F> __device__ __forceinline__ void mini_gemm(const bf16_t* A, const bf16_t* Bt, int K, int N, int gw, int NGW, int lane, F epi) {
    const int fr = lane & 15, fq = lane >> 4, ntask = 8 * (N / 32);
    for (int task = gw; task < ntask; task += NGW) {
        const int rt = task & 7, ct = task >> 3;
        const bf16x8* ap = (const bf16x8*)(A + (size_t)(rt * 16 + fr) * K + 8 * fq);
        const bf16x8* b0 = (const bf16x8*)(Bt + (size_t)(ct * 32 + fr) * K + 8 * fq);
        const bf16x8* b1 = (const bf16x8*)(Bt + (size_t)(ct * 32 + 16 + fr) * K + 8 * fq);
        f32x4 c0 = {0.f, 0.f, 0.f, 0.f}, c1 = {0.f, 0.f, 0.f, 0.f};
#pragma unroll 8
        for (int kk = 0; kk < K / 32; ++kk) {
            const bf16x8 a = ap[kk * 4];
            c0 = __builtin_amdgcn_mfma_f32_16x16x32_bf16(b0[kk * 4], a, c0, 0, 0, 0);
            c1 = __builtin_amdgcn_mfma_f32_16x16x32_bf16(b1[kk * 4], a, c1, 0, 0, 0);
        }
        epi(rt * 16 + fr, ct * 32 + 4 * fq, c0); epi(rt * 16 + fr, ct * 32 + 16 + 4 * fq, c1);
    }
}

__device__ __forceinline__ void transpose_item(const float* W, int N, int K, const float* gain, bf16_t* dst, LAS float* scr, int k0, int n0, int lane) {
#pragma unroll 8
    for (int i = 0; i < 32; ++i) { const int kk = 2 * i + (lane >> 5); const float gk = gain ? gain[k0 + kk] : 1.0f; scr[kk * 33 + (lane & 31)] = W[(size_t)(k0 + kk) * N + n0 + (lane & 31)] * gk; }
    LDS_WAIT();
    const int c = lane & 7;
#pragma unroll
    for (int j = 0; j < 4; ++j) { const int n = (lane >> 3) + 8 * j; const LAS float* s = scr + (8 * c) * 33 + n;
        u32x4 o; o.x = pk2(s[0 * 33], s[1 * 33]); o.y = pk2(s[2 * 33], s[3 * 33]); o.z = pk2(s[4 * 33], s[5 * 33]); o.w = pk2(s[6 * 33], s[7 * 33]);
        *(u32x4*)(dst + (size_t)n * K + k0 + 8 * c) = o; }
    LDS_WAIT();
}
__device__ __forceinline__ float rope_inv(int i) {
    return i == 0 ? 1.0f : i == 1 ? 0.19392274474868576f : i == 2 ? 0.03760603093086393f : i == 3 ? 0.007292664737217109f : i == 4 ? 0.001414213562373095f :
           i == 5 ? 0.0002742481756762073f : i == 6 ? 5.318295896944988e-05f : 1.031338537721246e-05f;
}

__device__ __forceinline__ void prologue(ArgP P, LAS unsigned char* lds, int gw, int NGW, int wave, int lane) {
    unsigned char* ws = P->ws;
    LAS float* scr = (LAS float*)(lds + wave * 8704);
    bf16_t* W1t = (bf16_t*)(ws + WS_W1); bf16_t* W2t = (bf16_t*)(ws + WS_W2); bf16_t* W3t = (bf16_t*)(ws + WS_W3); bf16_t* W4t = (bf16_t*)(ws + WS_W4);
    constexpr int I1 = 16 * 192, I2 = 32 * 32, I3 = 16 * 16, I4 = 16 * 64, I5 = 16 * 32;
    for (int it = gw; it < I1 + I2 + I3 + I4 + I5; it += NGW) {
        int r = it;
        if (r < I1) { const int kb = r / 192, nb = r % 192, n0 = 32 * nb, ty = n0 >> 11, ch = n0 & 2047;
            const int drow = ty == 1 ? ch : 2048 + (ch >> 7) * 256 + (ch & 127) + (ty == 2 ? 128 : 0);
            transpose_item(P->w_in_a, 6144, 1024, P->norm_a, W1t + (size_t)drow * 1024, scr, 64 * kb, n0, lane); continue; }
        r -= I1;
        if (r < I2) { const int kb = r / 32, nb = r % 32; transpose_item(P->w_out_a, 1024, 2048, nullptr, W2t + (size_t)(32 * nb) * 2048, scr, 64 * kb, 32 * nb, lane); continue; }
        r -= I2;
        if (r < I3) { const int kb = r / 16, nb = r % 16; transpose_item(P->w_kv, 512, 1024, P->kv_norm, W3t + (size_t)(32 * nb) * 1024, scr, 64 * kb, 32 * nb, lane); continue; }
        r -= I3;
        if (r < I4) { const int kb = r / 64, nb = r % 64; transpose_item(P->w_in_b, 2048, 1024, P->norm_b, W3t + (size_t)(512 + 32 * nb) * 1024, scr, 64 * kb, 32 * nb, lane); continue; }
        r -= I4;
        { const int kb = r / 32, nb = r % 32; transpose_item(P->w_out_b, 1024, 1024, nullptr, W4t + (size_t)(32 * nb) * 1024, scr, 64 * kb, 32 * nb, lane); }
    }
    bf16_t* XN = (bf16_t*)(ws + WS_XN);
    for (int row = gw; row < TT; row += NGW) {
        const float* xr = row < TP ? P->x_prompt + (size_t)row * DM : P->x_sample + (size_t)(row - TP) * DM;
        f32x4 v[4]; float s = 0.f;
#pragma unroll
        for (int j = 0; j < 4; ++j) { v[j] = *(const f32x4*)(xr + 4 * lane + 256 * j); s += (v[j][0] * v[j][0] + v[j][1] * v[j][1]) + (v[j][2] * v[j][2] + v[j][3] * v[j][3]); }
        const float rs = rsqrtf(wave_sum(s) * (1.0f / DM) + EPS);
#pragma unroll
        for (int j = 0; j < 4; ++j) { u32x2 o; o.x = pk2(v[j][0] * rs, v[j][1] * rs); o.y = pk2(v[j][2] * rs, v[j][3] * rs); *(u32x2*)(XN + (size_t)row * DM + 4 * lane + 256 * j) = o; }
    }
    const int gt = gw * 64 + lane, NGT = NGW * 64;
    float* small = (float*)(ws + WS_SMALL);
    for (int i = gt; i < 3 * 32768; i += NGT) small[i] = 0.f;
    float* rope = small + 3 * 32768;
    for (int i = gt; i < 2049 * 8; i += NGT) {
        const int idx = i >> 3, k = i & 7; const float pos = idx < 2048 ? (float)idx : 8192.0f;
        const float ang = pos * rope_inv(k);
        double rev = (double)ang * 0.15915494309189535; rev -= floor(rev);
        const float rf = (float)rev;
        rope[idx * 16 + k] = __builtin_amdgcn_cosf(rf); rope[idx * 16 + 8 + k] = __builtin_amdgcn_sinf(rf);
    }
    for (int i = gt; i < 2 * 128 * 127 * 64; i += NGT) {
        const int which = i >= 128 * 127 * 64; const int r = which ? i - 128 * 127 * 64 : i;
        const int b = r / (127 * 64), rem = r % (127 * 64), j = rem >> 6, q = rem & 63;
        const float* src = (which ? P->cache_v : P->cache_k) + ((size_t)(b * 128 + j + 1)) * 256 + 4 * q;
        float* dst = P->out + (which ? OUT_VS : OUT_KS) + ((size_t)(b * 128 + j)) * 256 + 4 * q;
        *(f32x4*)dst = *(const f32x4*)src;
    }
}

__device__ __forceinline__ void attn_prompt(LAS unsigned char* lds, const bf16_t* Qb, const bf16_t* Kb, const bf16_t* Vb, const bf16_t* Gb, const float* sinks, bf16_t* OG, int G, int bid, int tid, int wave, int lane) {
    LAS bf16_t* Kl = (LAS bf16_t*)lds;
    LAS bf16_t* Vl = Kl + 256 * 72;
    const int fr = lane & 15, fq = lane >> 4;
    for (int unit = bid; unit < 512; unit += G) {
        const int kvh = unit & 3, nb = (unit >> 2) & 15, b = unit >> 6;
        __syncthreads();
#pragma unroll
        for (int i = 0; i < 4; ++i) {
            const int c = tid + 512 * i, row = c >> 3, ch = c & 7, pos = 128 * nb - 128 + row;
            u32x4 kx = {0u, 0u, 0u, 0u}, vx = {0u, 0u, 0u, 0u};
            if (pos >= 0) { const size_t off = ((size_t)(b * 2048 + pos)) * 256 + kvh * 64 + ch * 8; kx = *(const u32x4*)(Kb + off); vx = *(const u32x4*)(Vb + off); }
            *(LAS u32x4*)(Kl + row * 72 + ch * 8) = kx;
            LAS bf16_t* vd = Vl + (ch * 8) * 264 + row;
            vd[0 * 264] = (bf16_t)(vx.x & 0xffffu); vd[1 * 264] = (bf16_t)(vx.x >> 16); vd[2 * 264] = (bf16_t)(vx.y & 0xffffu); vd[3 * 264] = (bf16_t)(vx.y >> 16);
            vd[4 * 264] = (bf16_t)(vx.z & 0xffffu); vd[5 * 264] = (bf16_t)(vx.z >> 16); vd[6 * 264] = (bf16_t)(vx.w & 0xffffu); vd[7 * 264] = (bf16_t)(vx.w >> 16);
        }
        __syncthreads();
        const int qt = wave;
        const size_t qrow = (size_t)(b * 2048 + 128 * nb + 16 * qt + fr);
        for (int hq = 0; hq < 4; ++hq) {
            const int head = 4 * kvh + hq;
            const bf16x8 q0 = *(const bf16x8*)(Qb + qrow * DM + head * 64 + 8 * fq), q1 = *(const bf16x8*)(Qb + qrow * DM + head * 64 + 32 + 8 * fq);
            f32x4 S[9];
#pragma unroll
            for (int t = 0; t < 9; ++t) {
                const LAS bf16_t* kp = Kl + (16 * (qt + t) + fr) * 72 + 8 * fq;
                const bf16x8 a0 = *(const LAS bf16x8*)kp, a1 = *(const LAS bf16x8*)(kp + 32);
                f32x4 s = {0.f, 0.f, 0.f, 0.f};
                s = __builtin_amdgcn_mfma_f32_16x16x32_bf16(a0, q0, s, 0, 0, 0);
                s = __builtin_amdgcn_mfma_f32_16x16x32_bf16(a1, q1, s, 0, 0, 0);
                S[t] = s;
            }
            const float sink = sinks[head];
            float mx = sink;
#pragma unroll
            for (int t = 0; t < 9; ++t)
#pragma unroll
                for (int e = 0; e < 4; ++e) {
                    const int dl = 16 * t + 4 * fq + e - fr, j = 16 * (qt + t) + 4 * fq + e;
                    const bool ok = dl >= 0 && dl <= 128 && (nb > 0 || j >= 128);
                    S[t][e] = ok ? S[t][e] : -INFINITY;
                    mx = fmaxf(mx, S[t][e]);
                }
            mx = fmaxf(mx, __shfl_xor(mx, 16)); mx = fmaxf(mx, __shfl_xor(mx, 32));
            float sum = 0.f;
#pragma unroll
            for (int t = 0; t < 9; ++t)
#pragma unroll
                for (int e = 0; e < 4; ++e) { const float p = __expf(S[t][e] - mx); S[t][e] = p; sum += p; }
            sum += __shfl_xor(sum, 16); sum += __shfl_xor(sum, 32);
            const float inv = 1.0f / (sum + __expf(sink - mx));
            f32x4 O[4];
#pragma unroll
            for (int dt = 0; dt < 4; ++dt) O[dt] = (f32x4){0.f, 0.f, 0.f, 0.f};
#pragma unroll
            for (int tp = 0; tp < 5; ++tp) {
                const int ta = 2 * tp, tb = 2 * tp + 1 < 9 ? 2 * tp + 1 : 8;
                const f32x4 pa = S[ta], pb = (2 * tp + 1 < 9) ? S[tb] : (f32x4){0.f, 0.f, 0.f, 0.f};
                const bf16x8 bfv = __builtin_bit_cast(bf16x8, pack8(pa, pb));
#pragma unroll
                for (int dt = 0; dt < 4; ++dt) {
                    const LAS bf16_t* vp = Vl + (16 * dt + fr) * 264 + 4 * fq;
                    u32x4 av; const u32x2 lo = *(const LAS u32x2*)(vp + 16 * (qt + ta)), hi = *(const LAS u32x2*)(vp + 16 * (qt + tb));
                    av.x = lo.x; av.y = lo.y; av.z = hi.x; av.w = hi.y;
                    O[dt] = __builtin_amdgcn_mfma_f32_16x16x32_bf16(__builtin_bit_cast(bf16x8, av), bfv, O[dt], 0, 0, 0);
                }
            }
#pragma unroll
            for (int dt = 0; dt < 4; ++dt) {
                const size_t off = qrow * DM + head * 64 + 16 * dt + 4 * fq;
                const u32x2 gg = *(const u32x2*)(Gb + off);
                u32x2 o;
                o.x = pk2(O[dt][0] * inv * __uint_as_float(gg.x << 16), O[dt][1] * inv * __uint_as_float(gg.x & 0xffff0000u));
                o.y = pk2(O[dt][2] * inv * __uint_as_float(gg.y << 16), O[dt][3] * inv * __uint_as_float(gg.y & 0xffff0000u));
                *(u32x2*)(OG + off) = o;
            }
        }
    }
}

__device__ __forceinline__ void attn_sample(const float* cache_k, const float* cache_v, const float* sinks_b, float* out, const float* KVQGS, const float* rope, bf16_t* OG, int gw, int NGW, int lane) {
    for (int task = gw; task < 512; task += NGW) {
        const int b = task >> 2, kvh = task & 3;
        const float* rowp = KVQGS + (size_t)b * 2560;
        const float* rp = rope + 2048 * 16;
        const float cs = rp[lane & 7], sn = rp[8 + (lane & 7)];
        float q[4];
#pragma unroll
        for (int hq = 0; hq < 4; ++hq) {
            float x = rowp[512 + (4 * kvh + hq) * 64 + lane]; const float pr = __shfl_xor(x, 8);
            if (lane < 8) x = x * cs - pr * sn; else if (lane < 16) x = x * cs + pr * sn;
            q[hq] = x * 0.125f;
        }
        float kn = rowp[kvh * 64 + lane]; { const float pr = __shfl_xor(kn, 8); if (lane < 8) kn = kn * cs - pr * sn; else if (lane < 16) kn = kn * cs + pr * sn; }
        const float vn = rowp[256 + kvh * 64 + lane];
        out[OUT_KS + ((size_t)(b * 128 + 127)) * 256 + kvh * 64 + lane] = kn;
        out[OUT_VS + ((size_t)(b * 128 + 127)) * 256 + kvh * 64 + lane] = vn;
        const float* k0p = cache_k + ((size_t)(b * 128 + lane)) * 256 + kvh * 64;
        const float* k1p = k0p + 64 * 256;
        float s0[4] = {0.f, 0.f, 0.f, 0.f}, s1[4] = {0.f, 0.f, 0.f, 0.f};
#pragma unroll
        for (int d4 = 0; d4 < 16; ++d4) {
            const f32x4 ka = *(const f32x4*)(k0p + 4 * d4), kb = *(const f32x4*)(k1p + 4 * d4);
#pragma unroll
            for (int c = 0; c < 4; ++c)
#pragma unroll
                for (int hq = 0; hq < 4; ++hq) { const float qd = __int_as_float(__builtin_amdgcn_readlane(__float_as_int(q[hq]), 4 * d4 + c)); s0[hq] += qd * ka[c]; s1[hq] += qd * kb[c]; }
        }
        float o[4];
#pragma unroll
        for (int hq = 0; hq < 4; ++hq) {
            const float snew = wave_sum(q[hq] * kn), sink = sinks_b[4 * kvh + hq];
            const float mx = fmaxf(fmaxf(wave_max(fmaxf(s0[hq], s1[hq])), snew), sink);
            const float p0 = __expf(s0[hq] - mx), p1 = __expf(s1[hq] - mx), pn = __expf(snew - mx);
            const float den = wave_sum(p0 + p1) + pn + __expf(sink - mx);
            s0[hq] = p0 / den; s1[hq] = p1 / den; o[hq] = (pn / den) * vn;
        }
        const float* vp = cache_v + ((size_t)(b * 128)) * 256 + kvh * 64 + lane;
#pragma unroll 8
        for (int key = 0; key < 64; ++key) {
            const float va = vp[(size_t)key * 256], vb = vp[(size_t)(key + 64) * 256];
#pragma unroll
            for (int hq = 0; hq < 4; ++hq) {
                o[hq] += __int_as_float(__builtin_amdgcn_readlane(__float_as_int(s0[hq]), key)) * va;
                o[hq] += __int_as_float(__builtin_amdgcn_readlane(__float_as_int(s1[hq]), key)) * vb;
            }
        }
#pragma unroll
        for (int hq = 0; hq < 4; ++hq) {
            const int col = (4 * kvh + hq) * 64 + lane;
            const float gt = silu(rowp[1536 + col]);
            const unsigned w = pk2(o[hq] * gt, 0.f);
            OG[(size_t)(TP + b) * DM + col] = (bf16_t)(w & 0xffffu);
        }
    }
}

__device__ __forceinline__ ArgP args_ptr() { ArgP p = (ArgP)__builtin_amdgcn_kernarg_segment_ptr(); asm volatile("" : "+s"(p)); return p; }
#define WSP(T, off) ((T*)(ws + (off)))
#define SMALLF(i) (WSP(float, WS_SMALL) + (i) * 32768)

__global__ void __launch_bounds__(512, 2) yoco_fwd(Params Pin) {
    extern __shared__ __attribute__((aligned(16))) unsigned char lds_raw[];
    LAS unsigned char* lds = (LAS unsigned char*)lds_raw;
    cg::grid_group grid = cg::this_grid();
    const int tid = threadIdx.x, lane = tid & 63, wave = __builtin_amdgcn_readfirstlane(tid >> 6);
    const int G = gridDim.x, bid = blockIdx.x, gw = bid * NWV + wave, NGW = G * NWV;

    { ArgP A = args_ptr(); prologue(A, lds, gw, NGW, wave, lane); }
    grid.sync();

    {
        ArgP A = args_ptr(); unsigned char* ws = A->ws;
        pg8::Gemm g{WSP(bf16_t, WS_W1), WSP(bf16_t, WS_XN), AW, TP, DM}; pg8::StaticOrder S; S.init(AW, TP, G, bid);
        EpiVT E{WSP(bf16_t, WS_VT), SMALLF(0)};
        pg8::gemm_phase<EpiVT, pg8::StaticOrder, true, true>(lds, g, S, E);
    }
    {
        ArgP A = args_ptr(); unsigned char* ws = A->ws; float* UVGS = WSP(float, WS_UVGS);
        mini_gemm(WSP(bf16_t, WS_XN) + (size_t)TP * DM, WSP(bf16_t, WS_W1), DM, 6144, gw, NGW, lane, [=](int row, int n, f32x4 v) {
            int ty, ch; if (n < 2048) { ty = 1; ch = n; } else { const int t = (n - 2048) >> 8, w = (n - 2048) & 255; if (w < 128) { ty = 0; ch = 128 * t + w; } else { ty = 2; ch = 128 * t + w - 128; } }
            *(f32x4*)(UVGS + ((size_t)row * 3 + ty) * AW + ch) = v; });
    }
    grid.sync();

    {
        ArgP A = args_ptr(); unsigned char* ws = A->ws;
        pg8::Gemm g{WSP(bf16_t, WS_XN), WSP(bf16_t, WS_W1) + (size_t)2048 * DM, TP, 4096, DM}; pg8::StaticOrder S; S.init(TP, 4096, G, bid);
        EpiUG E{WSP(bf16_t, WS_VT), SMALLF(0), A->w_s_a, A->b_s_a, A->v_norm_a, WSP(bf16_t, WS_Y)};
        pg8::gemm_phase<EpiUG, pg8::StaticOrder, true, true>(lds, g, S, E);
    }
    {
        ArgP A = args_ptr(); unsigned char* ws = A->ws; const float* UVGS = WSP(float, WS_UVGS); bf16_t* Y = WSP(bf16_t, WS_Y);
        const float* v_norm = A->v_norm_a; const float* w_s = A->w_s_a; const float* b_s = A->b_s_a; float* out = A->out;
        for (int b = gw; b < TS; b += NGW) {
            const float* ur = UVGS + (size_t)b * 3 * AW; const float* vr = ur + AW; const float* gr = ur + 2 * AW;
            f32x4 vv[8]; float s = 0.f;
#pragma unroll
            for (int i = 0; i < 8; ++i) { vv[i] = *(const f32x4*)(vr + 4 * (lane + 64 * i)); s += (vv[i][0] * vv[i][0] + vv[i][1] * vv[i][1]) + (vv[i][2] * vv[i][2] + vv[i][3] * vv[i][3]); }
            const float rs = rsqrtf(wave_sum(s) * (1.0f / AW) + EPS);
#pragma unroll
            for (int i = 0; i < 8; ++i) {
                const int c = 4 * (lane + 64 * i), gi = c >> 8;
                const f32x4 gvv = *(const f32x4*)(v_norm + c), uu = *(const f32x4*)(ur + c), gg = *(const f32x4*)(gr + c);
                const float w00 = w_s[(size_t)gi * 128 * 128], b0 = b_s[gi * 128];
                f32x4 vn, y;
#pragma unroll
                for (int e = 0; e < 4; ++e) { vn[e] = vv[i][e] * rs * gvv[e]; y[e] = uu[e] * (w00 * vn[e] + b0) * silu(gg[e]); }
                *(f32x4*)(out + OUT_AV + (size_t)b * AW + c) = vn;
                u32x2 o; o.x = pk2(y[0], y[1]); o.y = pk2(y[2], y[3]);
                *(u32x2*)(Y + (size_t)(TP + b) * AW + c) = o;
            }
        }
    }
    grid.sync();

    {
        ArgP A = args_ptr(); unsigned char* ws = A->ws;
        pg8::Gemm g{WSP(bf16_t, WS_Y), WSP(bf16_t, WS_W2), TP, DM, AW}; pg8::StaticOrder S; S.init(TP, DM, G, bid);
        EpiRes<true> E{A->x_prompt, A->out, WSP(bf16_t, WS_XN), SMALLF(1)};
        pg8::gemm_phase<EpiRes<true>, pg8::StaticOrder, true, true>(lds, g, S, E);
    }
    {
        ArgP A = args_ptr(); unsigned char* ws = A->ws; const float* xs = A->x_sample; float* H = A->out; bf16_t* H1b = WSP(bf16_t, WS_XN); float* hsq = SMALLF(1);
        mini_gemm(WSP(bf16_t, WS_Y) + (size_t)TP * AW, WSP(bf16_t, WS_W2), AW, DM, gw, NGW, lane, [=](int row, int n, f32x4 v) {
            const f32x4 h = v + *(const f32x4*)(xs + (size_t)row * DM + n);
            *(f32x4*)(H + (size_t)(TP + row) * DM + n) = h;
            u32x2 o; o.x = pk2(h[0], h[1]); o.y = pk2(h[2], h[3]); *(u32x2*)(H1b + (size_t)(TP + row) * DM + n) = o;
            float s = (h[0] * h[0] + h[1] * h[1]) + (h[2] * h[2] + h[3] * h[3]); s += __shfl_xor(s, 16); s += __shfl_xor(s, 32);
            if ((threadIdx.x & 63) < 16) unsafeAtomicAdd(hsq + TP + row, s); });
    }
    grid.sync();

    {
        ArgP A = args_ptr(); unsigned char* ws = A->ws; float* out = A->out;
        pg8::Gemm g{WSP(bf16_t, WS_XN), WSP(bf16_t, WS_W3), TP, 2560, DM}; pg8::StaticOrder S; S.init(TP, 2560, G, bid);
        Epi3 E{SMALLF(1), SMALLF(3), WSP(bf16_t, WS_Y), WSP(bf16_t, WS_Y) + (size_t)TP * 256, WSP(bf16_t, WS_VT), WSP(bf16_t, WS_VT) + (size_t)TP * DM, out + OUT_KP, out + OUT_VP};
        pg8::gemm_phase<Epi3, pg8::StaticOrder, true, true>(lds, g, S, E);
    }
    {
        ArgP A = args_ptr(); unsigned char* ws = A->ws; float* KVQGS = WSP(float, WS_KVQGS); const float* hsq = SMALLF(1);
        mini_gemm(WSP(bf16_t, WS_XN) + (size_t)TP * DM, WSP(bf16_t, WS_W3), DM, 2560, gw, NGW, lane, [=](int row, int n, f32x4 v) {
            const float rs = rsqrtf(hsq[TP + row] * (1.0f / DM) + EPS);
            *(f32x4*)(KVQGS + (size_t)row * 2560 + n) = v * rs; });
    }
    grid.sync();

    {
        ArgP A = args_ptr(); unsigned char* ws = A->ws;
        attn_prompt(lds, WSP(bf16_t, WS_VT), WSP(bf16_t, WS_Y), WSP(bf16_t, WS_Y) + (size_t)TP * 256, WSP(bf16_t, WS_VT) + (size_t)TP * DM, A->sinks_b, WSP(bf16_t, WS_XN), G, bid, tid, wave, lane);
    }
    {
        ArgP A = args_ptr(); unsigned char* ws = A->ws;
        attn_sample(A->cache_k, A->cache_v, A->sinks_b, A->out, WSP(float, WS_KVQGS), SMALLF(3), WSP(bf16_t, WS_XN), gw, NGW, lane);
    }
    grid.sync();

    {
        ArgP A = args_ptr(); unsigned char* ws = A->ws; float* H = A->out;
        pg8::Gemm g{WSP(bf16_t, WS_XN), WSP(bf16_t, WS_W4), TP, DM, DM}; pg8::StaticOrder S; S.init(TP, DM, G, bid);
        EpiRes<false> E{H, H, nullptr, SMALLF(2)};
        pg8::gemm_phase<EpiRes<false>, pg8::StaticOrder, true, true>(lds, g, S, E);
    }
    {
        ArgP A = args_ptr(); unsigned char* ws = A->ws; float* H = A->out; float* h2sq = SMALLF(2);
        mini_gemm(WSP(bf16_t, WS_XN) + (size_t)TP * DM, WSP(bf16_t, WS_W4), DM, DM, gw, NGW, lane, [=](int row, int n, f32x4 v) {
            float* hp = H + (size_t)(TP + row) * DM + n;
            const f32x4 h = v + *(const f32x4*)hp; *(f32x4*)hp = h;
            float s = (h[0] * h[0] + h[1] * h[1]) + (h[2] * h[2] + h[3] * h[3]); s += __shfl_xor(s, 16); s += __shfl_xor(s, 32);
            if ((threadIdx.x & 63) < 16) unsafeAtomicAdd(h2sq + TP + row, s); });
    }
    grid.sync();

    {
        ArgP A = args_ptr(); unsigned char* ws = A->ws; float* H = A->out; const float* h2sq = SMALLF(2); const float* fnp = A->final_norm;
        for (int row = gw; row < TT; row += NGW) {
            const float rs = rsqrtf(h2sq[row] * (1.0f / DM) + EPS);
            float* hp = H + (size_t)row * DM;
#pragma unroll
            for (int j = 0; j < 4; ++j) { const int c = 4 * lane + 256 * j; const f32x4 h = *(const f32x4*)(hp + c), fn = *(const f32x4*)(fnp + c); *(f32x4*)(hp + c) = h * rs * fn; }
        }
    }
}

extern "C" void kernel_launch(void* const* d_in, const int* in_sizes, int n_in, void* d_out, int out_size, void* d_ws, size_t ws_size, hipStream_t stream) {
    constexpr int LDS_BYTES = pg8::STAGE_BYTES;
    static int grid_blocks = 0;
    if (grid_blocks == 0) {
        if (n_in != 17 || ws_size < WS_END) { fprintf(stderr, "kernel_launch: unexpected inputs (n_in %d, ws %zu)\n", n_in, ws_size); grid_blocks = -1; return; }
        int dev = 0, cus = 0, per_cu = 0;
        hipGetDevice(&dev); hipDeviceGetAttribute(&cus, hipDeviceAttributeMultiprocessorCount, dev);
        if (hipFuncSetAttribute((const void*)yoco_fwd, hipFuncAttributeMaxDynamicSharedMemorySize, LDS_BYTES) != hipSuccess) { fprintf(stderr, "kernel_launch: hipFuncSetAttribute failed\n"); grid_blocks = -1; return; }
        if (hipOccupancyMaxActiveBlocksPerMultiprocessor(&per_cu, (const void*)yoco_fwd, 512, LDS_BYTES) != hipSuccess || per_cu < 1) { fprintf(stderr, "kernel_launch: occupancy query says %d blocks per CU\n", per_cu); per_cu = 1; }
        (void)hipGetLastError();
        grid_blocks = cus;
    }
    if (grid_blocks < 0) return;
    Params p{};
    p.x_prompt = (const float*)d_in[0]; p.x_sample = (const float*)d_in[1]; p.cache_k = (const float*)d_in[2]; p.cache_v = (const float*)d_in[3];
    p.norm_a = (const float*)d_in[4]; p.w_in_a = (const float*)d_in[5]; p.v_norm_a = (const float*)d_in[6]; p.w_s_a = (const float*)d_in[7]; p.b_s_a = (const float*)d_in[8];
    p.w_out_a = (const float*)d_in[9]; p.kv_norm = (const float*)d_in[10]; p.w_kv = (const float*)d_in[11]; p.norm_b = (const float*)d_in[12]; p.w_in_b = (const float*)d_in[13];
    p.sinks_b = (const float*)d_in[14]; p.w_out_b = (const float*)d_in[15]; p.final_norm = (const float*)d_in[16];
    p.out = (float*)d_out; p.ws = (unsigned char*)d_ws;
    void* args[] = {&p};
    hipError_t e = hipLaunchCooperativeKernel((const void*)yoco_fwd, dim3(grid_blocks), dim3(512), args, LDS_BYTES, stream);
    if (e != hipSuccess) fprintf(stderr, "kernel_launch: cooperative launch failed: %s (grid %d)\n", hipGetErrorString(e), grid_blocks);
}
```

```cpp
#include <hip/hip_runtime.h>
#include <hip/hip_cooperative_groups.h>
#include <cstdio>
#include <cstdint>
namespace cg = cooperative_groups;
namespace pg8 {
#define PG8_LAS __attribute__((address_space(3)))
typedef unsigned short bf16_t;
typedef short bf16x8 __attribute__((ext_vector_type(8)));
typedef float f32x4 __attribute__((ext_vector_type(4)));
typedef unsigned u32x4 __attribute__((ext_vector_type(4)));
constexpr int BM = 256, BK = 64, HALF = 128, HTB = HALF * BK * 2  , STAGE_BYTES = 8 * HTB, NXCD = 8, WGM = 8;

__host__ __device__ __forceinline__ int lds_byte(int r, int c) { const int st = (r >> 4) * 2 + (c >> 5), rr = r & 15, cc = c & 31, ob = rr * 64 + cc * 2; return st * 1024 + (ob ^ (((ob >> 9) & 1) << 5)); }
__host__ __device__ __forceinline__ void stage_rc(int b, int& R, int& C) { const int st = b / 1024, sb = b % 1024, swz = sb ^ (((sb >> 9) & 1) << 5); R = (st >> 1) * 16 + swz / 64; C = (st & 1) * 32 + (swz % 64) / 2; }
__host__ __device__ __forceinline__ int perm32(int rho) { const int n = rho >> 4, i = rho & 15; return 8 * (i >> 2) + 4 * n + (i & 3); }

struct Unit { int pm, pn; };
struct Gemm { const bf16_t* A; const bf16_t* Bt; int M, N, K; };

struct StaticOrder {
    int nM, nN, nwg, G, c;
    __host__ __device__ void init(int M, int N, int G_, int c_) { nM = M / BM; nN = N / BM; nwg = nM * nN; G = G_; c = c_; }
    __host__ __device__ bool next(int i, Unit& u) const {
        const long L = (long)i * G + c; if (L >= nwg) return false;
        int wgid = (int)L; { const int q = nwg / NXCD, r = nwg % NXCD, xcd = wgid % NXCD, off = wgid / NXCD; wgid = (xcd < r ? xcd * (q + 1) : r * (q + 1) + (xcd - r) * q) + off; }
        const int nig = WGM * nN, gid = wgid / nig, fm = gid * WGM, gsz = (nM - fm) < WGM ? (nM - fm) : WGM;
        u.pm = fm + ((wgid % nig) % gsz); u.pn = (wgid % nig) / gsz; return true;
    }
    __device__ __forceinline__ void a_ready(const Unit&) const {}
    __device__ __forceinline__ void done(const Unit&) const {}
};
__device__ __forceinline__ unsigned cvt_pk_bf16(float lo, float hi) { unsigned r; asm volatile("v_cvt_pk_bf16_f32 %0, %1, %2" : "=v"(r) : "v"(lo), "v"(hi)); return r; }
template <class Epi, class Sched, bool ALIGN_EPI = false, bool SP2 = false>
__device__ __forceinline__ void gemm_phase(PG8_LAS unsigned char* lds, const Gemm g, const Sched& S, const Epi& E) {
    const int tid = threadIdx.x, wid = __builtin_amdgcn_readfirstlane(tid >> 6), lane = tid & 63, wr = wid >> 2, wc = wid & 3, fr = lane & 15, fq = lane >> 4;
    const int K = g.K, nt = K / BK;
    unsigned voffA[2], voffB[2];
#pragma unroll
    for (int i = 0; i < 2; ++i) { int R, C; stage_rc(tid * 16 + i * 8192, R, C); const int Rb = Epi::PERM ? ((R & ~31) + perm32(R & 31)) : R;
        voffA[i] = (unsigned)(R * K + C) * 2u; voffB[i] = (unsigned)(Rb * K + C) * 2u; }
    const size_t kstep = (size_t)(BK * 2);
    const size_t hstep = (size_t)HALF * K * 2;
    const size_t tstep = 2 * hstep;
    const unsigned ldsw = (unsigned)wid * 1024u;
    const int aoff = lds_byte(wr * 64 + fr, fq * 8), boff = lds_byte(wc * 32 + fr, fq * 8);
#define PG8_SA(b, h) (((b) * 2 + (h)) * HTB)
#define PG8_SB(b, h) ((4 + (b) * 2 + (h)) * HTB)
#define PG8_STAGE(bufoff, gbase, voff) do { _Pragma("unroll") for (int _i = 0; _i < 2; ++_i) \
        __builtin_amdgcn_global_load_lds((const unsigned*)((const char*)(gbase) + (voff)[_i]), (PG8_LAS unsigned*)(lds + (bufoff) + ldsw + _i * 8192), 16, 0, 0); } while (0)
#define PG8_LDA(dst, b, h) do { _Pragma("unroll") for (int m = 0; m < 4; ++m) _Pragma("unroll") for (int k = 0; k < 2; ++k) dst[m][k] = *(const PG8_LAS bf16x8*)(lds + PG8_SA(b, h) + aoff + m * 2048 + k * 1024); } while (0)
#define PG8_LDB(dst, b, h) do { _Pragma("unroll") for (int n = 0; n < 2; ++n) _Pragma("unroll") for (int k = 0; k < 2; ++k) dst[n][k] = *(const PG8_LAS bf16x8*)(lds + PG8_SB(b, h) + boff + n * 2048 + k * 1024); } while (0)
#define PG8_MMA(ai, bj, At, Bt) do { __builtin_amdgcn_s_setprio(1); _Pragma("unroll") for (int m = 0; m < 4; ++m) _Pragma("unroll") for (int n = 0; n < 2; ++n) _Pragma("unroll") for (int k = 0; k < 2; ++k) \
        acc[ai][bj][m][n] = __builtin_amdgcn_mfma_f32_16x16x32_bf16(Bt[n][k], At[m][k], acc[ai][bj][m][n], 0, 0, 0); __builtin_amdgcn_s_setprio(0); } while (0)
#define PG8_WAIT_V(n) asm volatile("s_waitcnt vmcnt(" #n ")" ::: "memory")
#define PG8_WAIT_L(n) asm volatile("s_waitcnt lgkmcnt(" #n ")" ::: "memory")
#define PG8_BAR __builtin_amdgcn_s_barrier()
#define PG8_SCHED __builtin_amdgcn_sched_barrier(0)
    Unit cur, nxt; int ui = 0;
    if (!S.next(0, cur)) return;
    f32x4 acc[2][2][4][2];
#pragma unroll
    for (int a = 0; a < 2; ++a)
#pragma unroll
        for (int b = 0; b < 2; ++b)
#pragma unroll
            for (int m = 0; m < 4; ++m)
#pragma unroll
                for (int n = 0; n < 2; ++n) acc[a][b][m][n] = (f32x4){0.f, 0.f, 0.f, 0.f};
    bf16x8 At[4][2], B0[2][2], B1[2][2];
    const char* cA = (const char*)g.A + (size_t)cur.pm * tstep; const char* cB = (const char*)g.Bt + (size_t)cur.pn * tstep;
    S.a_ready(cur);
    if constexpr (SP2) {
        PG8_STAGE(PG8_SB(0, 0), cB, voffB); PG8_STAGE(PG8_SB(0, 1), cB + hstep, voffB); PG8_STAGE(PG8_SA(0, 0), cA, voffA); PG8_STAGE(PG8_SA(0, 1), cA + hstep, voffA);
        if (wr == 1) PG8_BAR;
        PG8_WAIT_V(2); PG8_BAR;
        PG8_STAGE(PG8_SB(1, 0), cB + kstep, voffB); PG8_STAGE(PG8_SA(1, 0), cA + kstep, voffA); PG8_STAGE(PG8_SB(1, 1), cB + hstep + kstep, voffB);
        PG8_WAIT_V(6); PG8_BAR;
    } else {
        PG8_STAGE(PG8_SB(0, 0), cB, voffB); PG8_STAGE(PG8_SA(0, 0), cA, voffA); PG8_STAGE(PG8_SB(0, 1), cB + hstep, voffB); PG8_STAGE(PG8_SA(0, 1), cA + hstep, voffA);
        if (wr == 1) PG8_BAR;
        PG8_WAIT_V(4); PG8_BAR;
        PG8_STAGE(PG8_SB(1, 0), cB + kstep, voffB); PG8_STAGE(PG8_SA(1, 0), cA + kstep, voffA); PG8_STAGE(PG8_SB(1, 1), cB + hstep + kstep, voffB);
        PG8_WAIT_V(6); PG8_BAR;
    }
    for (;;) {
        const bool has_next = S.next(ui + 1, nxt);
        const char* nA = has_next ? (const char*)g.A + (size_t)nxt.pm * tstep : cA; const char* nB = has_next ? (const char*)g.Bt + (size_t)nxt.pn * tstep : cB;
        for (int t = 0; t < nt; t += 2) {
            const bool last = (t == nt - 2);
            const char* a1 = cA + (size_t)(t + 1) * kstep;
            const char* a2 = last ? nA : cA + (size_t)(t + 2) * kstep; const char* b2 = last ? nB : cB + (size_t)(t + 2) * kstep;
            const char* a3 = a2 + kstep; const char* b3 = b2 + kstep;
            if (last && has_next) S.a_ready(nxt);
            if constexpr (SP2) {
            PG8_LDB(B0, 0, 0); PG8_LDB(B1, 0, 1); PG8_SCHED; PG8_LDA(At, 0, 0); PG8_STAGE(PG8_SA(1, 1), a1 + hstep, voffA);
            PG8_WAIT_V(8); PG8_WAIT_L(0); PG8_BAR; PG8_MMA(0, 0, At, B0); PG8_MMA(0, 1, At, B1); PG8_BAR; PG8_SCHED;
            PG8_LDA(At, 0, 1); PG8_STAGE(PG8_SB(0, 0), b2, voffB); PG8_STAGE(PG8_SB(0, 1), b2 + hstep, voffB); PG8_STAGE(PG8_SA(0, 0), a2, voffA);
            PG8_WAIT_V(8); PG8_WAIT_L(0); PG8_BAR; PG8_MMA(1, 0, At, B0); PG8_MMA(1, 1, At, B1); PG8_BAR; PG8_SCHED;
            PG8_LDB(B0, 1, 0); PG8_LDB(B1, 1, 1); PG8_SCHED; PG8_LDA(At, 1, 0); PG8_STAGE(PG8_SA(0, 1), a2 + hstep, voffA);
            PG8_WAIT_V(8); PG8_WAIT_L(0); PG8_BAR; PG8_MMA(0, 0, At, B0); PG8_MMA(0, 1, At, B1); PG8_BAR; PG8_SCHED;
            PG8_LDA(At, 1, 1); PG8_STAGE(PG8_SB(1, 0), b3, voffB); PG8_STAGE(PG8_SB(1, 1), b3 + hstep, voffB); PG8_STAGE(PG8_SA(1, 0), a3, voffA);
            PG8_WAIT_V(8); PG8_WAIT_L(0); PG8_BAR; PG8_MMA(1, 0, At, B0); PG8_MMA(1, 1, At, B1); PG8_BAR; PG8_SCHED;
            } else {
            PG8_LDB(B0, 0, 0); PG8_SCHED; PG8_LDA(At, 0, 0); PG8_STAGE(PG8_SA(1, 1), a1 + hstep, voffA);
            PG8_WAIT_L(8); PG8_BAR; PG8_WAIT_L(0); PG8_MMA(0, 0, At, B0); PG8_BAR; PG8_SCHED;
            PG8_LDB(B1, 0, 1); PG8_STAGE(PG8_SB(0, 0), b2, voffB);
            PG8_BAR; PG8_WAIT_L(0); PG8_MMA(0, 1, At, B1); PG8_BAR;
            PG8_LDA(At, 0, 1); PG8_STAGE(PG8_SA(0, 0), a2, voffA);
            PG8_BAR; PG8_WAIT_L(0); PG8_MMA(1, 0, At, B0); PG8_BAR; PG8_SCHED;
            PG8_STAGE(PG8_SB(0, 1), b2 + hstep, voffB);
            PG8_WAIT_V(6); PG8_BAR; PG8_MMA(1, 1, At, B1); PG8_BAR;
            PG8_LDB(B0, 1, 0); PG8_SCHED; PG8_LDA(At, 1, 0); PG8_STAGE(PG8_SA(0, 1), a2 + hstep, voffA);
            PG8_WAIT_L(8); PG8_BAR; PG8_WAIT_L(0); PG8_MMA(0, 0, At, B0); PG8_BAR; PG8_SCHED;
            PG8_LDB(B1, 1, 1); PG8_STAGE(PG8_SB(1, 0), b3, voffB);
            PG8_BAR; PG8_WAIT_L(0); PG8_MMA(0, 1, At, B1); PG8_BAR;
            PG8_LDA(At, 1, 1); PG8_STAGE(PG8_SA(1, 0), a3, voffA);
            PG8_BAR; PG8_WAIT_L(0); PG8_MMA(1, 0, At, B0); PG8_BAR; PG8_SCHED;
            PG8_STAGE(PG8_SB(1, 1), b3 + hstep, voffB);
            PG8_WAIT_V(6); PG8_BAR; PG8_MMA(1, 1, At, B1); PG8_BAR;
            }
        }
        if constexpr (ALIGN_EPI) { if (wr == 0) PG8_BAR; }
        if constexpr (!Epi::AFTER_DRAIN) { E(acc, cur, wr, wc, fr, fq); S.done(cur); }
        if (!has_next) break;
#pragma unroll
        for (int a = 0; a < 2; ++a)
#pragma unroll
            for (int b = 0; b < 2; ++b)
#pragma unroll
                for (int m = 0; m < 4; ++m)
#pragma unroll
                    for (int n = 0; n < 2; ++n) acc[a][b][m][n] = (f32x4){0.f, 0.f, 0.f, 0.f};
        cur = nxt; cA = nA; cB = nB; ++ui;
        if constexpr (ALIGN_EPI) { if (wr == 1) PG8_BAR; }
    }
    PG8_WAIT_V(0);
    if constexpr (!ALIGN_EPI) { if (wr == 0) PG8_BAR; }
    PG8_BAR;
    if constexpr (Epi::AFTER_DRAIN) { E.fused(acc, cur, wr, wc, fr, fq, lds, wid, lane); S.done(cur); }
#undef PG8_SA
#undef PG8_SB
#undef PG8_STAGE
#undef PG8_LDA
#undef PG8_LDB
#undef PG8_MMA
#undef PG8_WAIT_V
#undef PG8_WAIT_L
#undef PG8_BAR
#undef PG8_SCHED
}
}

#define LAS __attribute__((address_space(3)))
using pg8::bf16_t; using pg8::bf16x8; using pg8::f32x4; using pg8::u32x4; using pg8::Unit;
typedef unsigned u32x2 __attribute__((ext_vector_type(2)));
constexpr int DM = 1024, TP = 16384, TS = 128, TT = TP + TS, AW = 2048, NWV = 8;
constexpr float EPS = 1e-5f;
constexpr size_t MiB = 1u << 20;
constexpr size_t WS_W1 = 0, WS_W2 = 12 * MiB, WS_W3 = 16 * MiB, WS_W4 = 21 * MiB, WS_SMALL = 23 * MiB, WS_UVGS = 24 * MiB, WS_KVQGS = 27 * MiB,
                 WS_XN = 29 * MiB  , WS_VT = 62 * MiB  , WS_Y = 126 * MiB  , WS_END = 191 * MiB;
constexpr size_t OUT_YS = (size_t)TP * DM, OUT_KP = OUT_YS + (size_t)TS * DM, OUT_VP = OUT_KP + 262144, OUT_KS = OUT_VP + 262144, OUT_VS = OUT_KS + 4194304, OUT_AV = OUT_VS + 4194304;

__device__ __forceinline__ unsigned pk2(float a, float b) { return pg8::cvt_pk_bf16(a, b); }
__device__ __forceinline__ float bf2f(unsigned short h) { return __uint_as_float(((unsigned)h) << 16); }
__device__ __forceinline__ float silu(float x) { return x / (1.0f + __expf(-x)); }
__device__ __forceinline__ float wave_sum(float v) {
#pragma unroll
    for (int o = 1; o < 64; o <<= 1) v += __shfl_xor(v, o);
    return v;
}
__device__ __forceinline__ float wave_max(float v) {
#pragma unroll
    for (int o = 1; o < 64; o <<= 1) v = fmaxf(v, __shfl_xor(v, o));
    return v;
}
__device__ __forceinline__ u32x4 pack8(const f32x4 a, const f32x4 b) { u32x4 w; w.x = pk2(a[0], a[1]); w.y = pk2(a[2], a[3]); w.z = pk2(b[0], b[1]); w.w = pk2(b[2], b[3]); return w; }
#define LDS_WAIT() asm volatile("s_waitcnt lgkmcnt(0)" ::: "memory")

struct Params {
    const float *x_prompt, *x_sample, *cache_k, *cache_v, *norm_a, *w_in_a, *v_norm_a, *w_s_a, *b_s_a, *w_out_a, *kv_norm, *w_kv, *norm_b, *w_in_b, *sinks_b, *w_out_b, *final_norm;
    float* out; unsigned char* ws;
};
typedef const __attribute__((address_space(4))) Params* ArgP;

struct EpiVT {
    static constexpr bool PERM = true, AFTER_DRAIN = false;
    bf16_t* VT; float* vsq;
    __device__ __forceinline__ void operator()(const f32x4 (&acc)[2][2][4][2], const Unit& u, int wr_, int wc_, int fr_, int fq_) const {
        int fr = fr_, fq = fq_, wr = wr_, wc = wc_; asm volatile("" : "+v"(fr), "+v"(fq), "+s"(wr), "+s"(wc));
        const int t0 = u.pn * 256 + wc * 32 + 8 * fq;
        float cs[2][8];
#pragma unroll
        for (int bj = 0; bj < 2; ++bj)
#pragma unroll
            for (int j = 0; j < 8; ++j) cs[bj][j] = 0.f;
#pragma unroll
        for (int ai = 0; ai < 2; ++ai)
#pragma unroll
            for (int m = 0; m < 4; ++m) {
                const int c = u.pm * 256 + ai * 128 + wr * 64 + m * 16 + fr;
#pragma unroll
                for (int bj = 0; bj < 2; ++bj) {
                    const f32x4 v0 = acc[ai][bj][m][0], v1 = acc[ai][bj][m][1];
                    *(u32x4*)(VT + (size_t)c * TP + t0 + 128 * bj) = pack8(v0, v1);
#pragma unroll
                    for (int e = 0; e < 4; ++e) { cs[bj][e] += v0[e] * v0[e]; cs[bj][4 + e] += v1[e] * v1[e]; }
                }
            }
#pragma unroll
        for (int bj = 0; bj < 2; ++bj)
#pragma unroll
            for (int j = 0; j < 8; ++j) {
                float s = cs[bj][j];
                s += __shfl_xor(s, 1); s += __shfl_xor(s, 2); s += __shfl_xor(s, 4); s += __shfl_xor(s, 8);
                if (fr == 0) unsafeAtomicAdd(vsq + t0 + 128 * bj + j, s);
            }
    }
};

struct EpiUG {
    static constexpr bool PERM = true, AFTER_DRAIN = false;
    const bf16_t* VT; const float* vsq; const float* w_s; const float* b_s; const float* gv; bf16_t* Y;
    __device__ __forceinline__ void operator()(const f32x4 (&acc)[2][2][4][2], const Unit& u, int wr_, int wc_, int fr_, int fq_) const {
        int fr = fr_, fq = fq_, wr = wr_, wc = wc_; asm volatile("" : "+v"(fr), "+v"(fq), "+s"(wr), "+s"(wc));
        const int g = u.pn >> 1, cb = 128 * u.pn + 32 * wc;
        const int chA0 = cb + 8 * (fr >> 2) + (fr & 3);
        const int chL = cb + 8 * fq;
        const f32x4 gv0 = *(const f32x4*)(gv + chL), gv1 = *(const f32x4*)(gv + chL + 4);
#pragma unroll
        for (int ai = 0; ai < 2; ++ai) {
            const int tok0 = (2 * u.pm + ai) * 128;
            const bf16_t* vbase = VT + (size_t)chA0 * TP + tok0 + 8 * fq;
            const float* qbase = vsq + tok0 + 8 * fq;
#pragma unroll
            for (int m = 0; m < 4; ++m) {
                const int i = 64 * wr + 16 * m + fr, kmax = (64 * wr + 16 * m + 15) >> 5;
                f32x4 z0 = {0.f, 0.f, 0.f, 0.f}, z1 = {0.f, 0.f, 0.f, 0.f};
                const float* wrow = w_s + ((size_t)g * 128 + i) * 128 + 8 * fq;
#pragma unroll
                for (int kk = 0; kk < 4; ++kk) {
                    if (kk <= kmax) {
                        const f32x4 w0 = *(const f32x4*)(wrow + 32 * kk), w1 = *(const f32x4*)(wrow + 32 * kk + 4);
                        const f32x4 q0 = *(const f32x4*)(qbase + 32 * kk), q1 = *(const f32x4*)(qbase + 32 * kk + 4);
                        const bf16x8 va0 = *(const bf16x8*)(vbase + 32 * kk), va1 = *(const bf16x8*)(vbase + (size_t)4 * TP + 32 * kk);
                        const int dj = i - (32 * kk + 8 * fq);
                        f32x4 t0, t1;
#pragma unroll
                        for (int e = 0; e < 4; ++e) {
                            const float a0 = w0[e] * rsqrtf(q0[e] * (1.0f / AW) + EPS), a1 = w1[e] * rsqrtf(q1[e] * (1.0f / AW) + EPS);
                            t0[e] = __int_as_float(__float_as_int(a0) & ~((dj - e) >> 31));
                            t1[e] = __int_as_float(__float_as_int(a1) & ~((dj - 4 - e) >> 31)); }
                        const bf16x8 bfv = __builtin_bit_cast(bf16x8, pack8(t0, t1));
                        z0 = __builtin_amdgcn_mfma_f32_16x16x32_bf16(va0, bfv, z0, 0, 0, 0);
                        z1 = __builtin_amdgcn_mfma_f32_16x16x32_bf16(va1, bfv, z1, 0, 0, 0);
                    }
                }
                const float bias = b_s[g * 128 + i];
                const f32x4 u0 = acc[ai][0][m][0], u1 = acc[ai][0][m][1], g0 = acc[ai][1][m][0], g1 = acc[ai][1][m][1];
                f32x4 y0, y1;
#pragma unroll
                for (int e = 0; e < 4; ++e) { y0[e] = u0[e] * (gv0[e] * z0[e] + bias) * silu(g0[e]); y1[e] = u1[e] * (gv1[e] * z1[e] + bias) * silu(g1[e]); }
                *(u32x4*)(Y + (size_t)(tok0 + i) * AW + chL) = pack8(y0, y1);
                asm volatile("" ::: "memory");
            }
        }
    }
};

template <bool WITH_BF16> struct EpiRes {
    static constexpr bool PERM = true, AFTER_DRAIN = false;
    const float* base; float* H; bf16_t* Hb; float* sq;
    __device__ __forceinline__ void operator()(const f32x4 (&acc)[2][2][4][2], const Unit& u, int wr_, int wc_, int fr_, int fq_) const {
        int fr = fr_, fq = fq_, wr = wr_, wc = wc_; asm volatile("" : "+v"(fr), "+v"(fq), "+s"(wr), "+s"(wc));
        const int col0 = u.pn * 256 + wc * 32 + 8 * fq;
#pragma unroll
        for (int ai = 0; ai < 2; ++ai)
#pragma unroll
            for (int m = 0; m < 4; ++m) {
                const int row = u.pm * 256 + ai * 128 + wr * 64 + m * 16 + fr; float s = 0.f;
#pragma unroll
                for (int bj = 0; bj < 2; ++bj) {
                    const size_t off = (size_t)row * DM + col0 + 128 * bj;
                    const f32x4 h0 = acc[ai][bj][m][0] + *(const f32x4*)(base + off), h1 = acc[ai][bj][m][1] + *(const f32x4*)(base + off + 4);
                    *(f32x4*)(H + off) = h0; *(f32x4*)(H + off + 4) = h1;
                    if (WITH_BF16) *(u32x4*)(Hb + off) = pack8(h0, h1);
#pragma unroll
                    for (int e = 0; e < 4; ++e) s += h0[e] * h0[e] + h1[e] * h1[e];
                }
                s += __shfl_xor(s, 16); s += __shfl_xor(s, 32);
                if (fq == 0) unsafeAtomicAdd(sq + row, s);
                if (m & 1) asm volatile("" ::: "memory");
            }
    }
};

struct Epi3 {
    static constexpr bool PERM = true, AFTER_DRAIN = false;
    const float* hsq; const float* rope; bf16_t *Kb, *Vb, *Qb, *Gb; float *outk, *outv;
    __device__ __forceinline__ void operator()(const f32x4 (&acc)[2][2][4][2], const Unit& u, int wr_, int wc_, int fr_, int fq_) const {
        int fr = fr_, fq = fq_, wr = wr_, wc = wc_; asm volatile("" : "+v"(fr), "+v"(fq), "+s"(wr), "+s"(wc));
        const int pn = u.pn; const bool rot = (pn == 0 || (pn >= 2 && pn < 6)) && ((wc & 1) == 0);
#pragma unroll
        for (int ai = 0; ai < 2; ++ai)
#pragma unroll
            for (int m = 0; m < 4; ++m) {
                const int row = u.pm * 256 + ai * 128 + wr * 64 + m * 16 + fr, pos = row & 2047, b = row >> 11;
                const float rs = rsqrtf(hsq[row] * (1.0f / DM) + EPS);
                const float* rp = rope + pos * 16;
#pragma unroll
                for (int bj = 0; bj < 2; ++bj) {
                    f32x4 v0 = acc[ai][bj][m][0] * rs, v1 = acc[ai][bj][m][1] * rs;
                    const int cw = 128 * bj + 32 * wc + 8 * fq;
                    if (rot) {
                        const f32x4 c0 = *(const f32x4*)(rp), c1 = *(const f32x4*)(rp + 4), s0 = *(const f32x4*)(rp + 8), s1 = *(const f32x4*)(rp + 12);
#pragma unroll
                        for (int e = 0; e < 4; ++e) {
                            const float p0 = __shfl_xor(v0[e], 16), p1 = __shfl_xor(v1[e], 16);
                            const float a0 = fq == 0 ? v0[e] * c0[e] - p0 * s0[e] : v0[e] * c0[e] + p0 * s0[e];
                            const float a1 = fq == 0 ? v1[e] * c1[e] - p1 * s1[e] : v1[e] * c1[e] + p1 * s1[e];
                            if (fq < 2) { v0[e] = a0; v1[e] = a1; }
                        }
                    }
                    if (pn == 0) {
                        *(u32x4*)(Kb + (size_t)row * 256 + cw) = pack8(v0, v1);
                        if (pos >= 1920) { float* o = outk + ((size_t)(b * 128 + pos - 1920)) * 256 + cw; *(f32x4*)o = v0; *(f32x4*)(o + 4) = v1; }
                    } else if (pn == 1) {
                        *(u32x4*)(Vb + (size_t)row * 256 + cw) = pack8(v0, v1);
                        if (pos >= 1920) { float* o = outv + ((size_t)(b * 128 + pos - 1920)) * 256 + cw; *(f32x4*)o = v0; *(f32x4*)(o + 4) = v1; }
                    } else if (pn < 6) {
                        *(u32x4*)(Qb + (size_t)row * DM + 256 * (pn - 2) + cw) = pack8(v0 * 0.125f, v1 * 0.125f);
                    } else {
                        f32x4 g0, g1;
#pragma unroll
                        for (int e = 0; e < 4; ++e) { g0[e] = silu(v0[e]); g1[e] = silu(v1[e]); }
                        *(u32x4*)(Gb + (size_t)row * DM + 256 * (pn - 6) + cw) = pack8(g0, g1);
                    }
                }
                asm volatile("" ::: "memory");
            }
    }
};


struct EpiNull {
    static constexpr bool PERM = true, AFTER_DRAIN = false;
    float* dummy;
    __device__ __forceinline__ void operator()(const f32x4 (&acc)[2][2][4][2], const Unit& u, int wr, int wc, int fr, int fq) const {
        float s = 0.f;
#pragma unroll
        for (int ai = 0; ai < 2; ++ai)
#pragma unroll
            for (int bj = 0; bj < 2; ++bj)
#pragma unroll
                for (int m = 0; m < 4; ++m)
#pragma unroll
                    for (int n = 0; n < 2; ++n) s += (acc[ai][bj][m][n][0] + acc[ai][bj][m][n][1]) + (acc[ai][bj][m][n][2] + acc[ai][bj][m][n][3]);
        if (s == 123456.789f) dummy[u.pm * 64 + u.pn + wr + wc + fr + fq] = s;
    }
};
template <class F> __device__ __forceinline__ void mini_gemm(const bf16_t* A, const bf16_t* Bt, int K, int N, int gw, int NGW, int lane, F epi) {
    const int fr = lane & 15, fq = lane >> 4, ntask = 8 * (N / 32);
    for (int task = gw; task < ntask; task += NGW) {
        const int rt = task & 7, ct = task >> 3;
        const bf16x8* ap = (const bf16x8*)(A + (size_t)(rt * 16 + fr) * K + 8 * fq);
        const bf16x8* b0 = (const bf16x8*)(Bt + (size_t)(ct * 32 + fr) * K + 8 * fq);
        const bf16x8* b1 = (const bf16x8*)(Bt + (size_t)(ct * 32 + 16 + fr) * K + 8 * fq);
        f32x4 c0 = {0.f, 0.f, 0.f, 0.f}, c1 = {0.f, 0.f, 0.f, 0.f};
        for (int kb = 0; kb < K / 32; kb += 8) {
            bf16x8 a[8], x0[8], x1[8];
#pragma unroll
            for (int i = 0; i < 8; ++i) { a[i] = ap[(kb + i) * 4]; x0[i] = b0[(kb + i) * 4]; x1[i] = b1[(kb + i) * 4]; }
            __builtin_amdgcn_sched_barrier(0);
#pragma unroll
            for (int i = 0; i < 8; ++i) {
                c0 = __builtin_amdgcn_mfma_f32_16x16x32_bf16(x0[i], a[i], c0, 0, 0, 0);
                c1 = __builtin_amdgcn_mfma_f32_16x16x32_bf16(x1[i], a[i], c1, 0, 0, 0);
            }
            __builtin_amdgcn_sched_barrier(0);
        }
        epi(rt * 16 + fr, ct * 32 + 4 * fq, c0); epi(rt * 16 + fr, ct * 32 + 16 + 4 * fq, c1);
    }
}

__device__ __forceinline__ void transpose_item(const float* W, int N, int K, const float* gain, bf16_t* dst, LAS float* scr, int k0, int n0, int lane) {
#pragma unroll 8
    for (int i = 0; i < 32; ++i) { const int kk = 2 * i + (lane >> 5); const float gk = gain ? gain[k0 + kk] : 1.0f; scr[kk * 33 + (lane & 31)] = W[(size_t)(k0 + kk) * N + n0 + (lane & 31)] * gk; }
    LDS_WAIT();
    const int c = lane & 7;
#pragma unroll
    for (int j = 0; j < 4; ++j) { const int n = (lane >> 3) + 8 * j; const LAS float* s = scr + (8 * c) * 33 + n;
        u32x4 o; o.x = pk2(s[0 * 33], s[1 * 33]); o.y = pk2(s[2 * 33], s[3 * 33]); o.z = pk2(s[4 * 33], s[5 * 33]); o.w = pk2(s[6 * 33], s[7 * 33]);
        *(u32x4*)(dst + (size_t)n * K + k0 + 8 * c) = o; }
    LDS_WAIT();
}
__device__ __forceinline__ float rope_inv(int i) {
    return i == 0 ? 1.0f : i == 1 ? 0.19392274474868576f : i == 2 ? 0.03760603093086393f : i == 3 ? 0.007292664737217109f : i == 4 ? 0.001414213562373095f :
           i == 5 ? 0.0002742481756762073f : i == 6 ? 5.318295896944988e-05f : 1.031338537721246e-05f;
}

__device__ __forceinline__ void prologue(ArgP P, LAS unsigned char* lds, int gw, int NGW, int wave, int lane) {
    unsigned char* ws = P->ws;
    LAS float* scr = (LAS float*)(lds + wave * 8704);
    bf16_t* W1t = (bf16_t*)(ws + WS_W1); bf16_t* W2t = (bf16_t*)(ws + WS_W2); bf16_t* W3t = (bf16_t*)(ws + WS_W3); bf16_t* W4t = (bf16_t*)(ws + WS_W4);
    constexpr int I1 = 16 * 192, I2 = 32 * 32, I3 = 16 * 16, I4 = 16 * 64, I5 = 16 * 32;
    for (int it = gw; it < I1 + I2 + I3 + I4 + I5; it += NGW) {
        int r = it;
        if (r < I1) { const int kb = r / 192, nb = r % 192, n0 = 32 * nb, ty = n0 >> 11, ch = n0 & 2047;
            const int drow = ty == 1 ? ch : 2048 + (ch >> 7) * 256 + (ch & 127) + (ty == 2 ? 128 : 0);
            transpose_item(P->w_in_a, 6144, 1024, P->norm_a, W1t + (size_t)drow * 1024, scr, 64 * kb, n0, lane); continue; }
        r -= I1;
        if (r < I2) { const int kb = r / 32, nb = r % 32; transpose_item(P->w_out_a, 1024, 2048, nullptr, W2t + (size_t)(32 * nb) * 2048, scr, 64 * kb, 32 * nb, lane); continue; }
        r -= I2;
        if (r < I3) { const int kb = r / 16, nb = r % 16; transpose_item(P->w_kv, 512, 1024, P->kv_norm, W3t + (size_t)(32 * nb) * 1024, scr, 64 * kb, 32 * nb, lane); continue; }
        r -= I3;
        if (r < I4) { const int kb = r / 64, nb = r % 64; transpose_item(P->w_in_b, 2048, 1024, P->norm_b, W3t + (size_t)(512 + 32 * nb) * 1024, scr, 64 * kb, 32 * nb, lane); continue; }
        r -= I4;
        { const int kb = r / 32, nb = r % 32; transpose_item(P->w_out_b, 1024, 1024, nullptr, W4t + (size_t)(32 * nb) * 1024, scr, 64 * kb, 32 * nb, lane); }
    }
    bf16_t* XN = (bf16_t*)(ws + WS_XN);
    for (int row = gw; row < TT; row += NGW) {
        const float* xr = row < TP ? P->x_prompt + (size_t)row * DM : P->x_sample + (size_t)(row - TP) * DM;
        f32x4 v[4]; float s = 0.f;
#pragma unroll
        for (int j = 0; j < 4; ++j) { v[j] = *(const f32x4*)(xr + 4 * lane + 256 * j); s += (v[j][0] * v[j][0] + v[j][1] * v[j][1]) + (v[j][2] * v[j][2] + v[j][3] * v[j][3]); }
        const float rs = rsqrtf(wave_sum(s) * (1.0f / DM) + EPS);
#pragma unroll
        for (int j = 0; j < 4; ++j) { u32x2 o; o.x = pk2(v[j][0] * rs, v[j][1] * rs); o.y = pk2(v[j][2] * rs, v[j][3] * rs); *(u32x2*)(XN + (size_t)row * DM + 4 * lane + 256 * j) = o; }
    }
    const int gt = gw * 64 + lane, NGT = NGW * 64;
    float* small = (float*)(ws + WS_SMALL);
    for (int i = gt; i < 3 * 32768; i += NGT) small[i] = 0.f;
    float* rope = small + 3 * 32768;
    for (int i = gt; i < 2049 * 8; i += NGT) {
        const int idx = i >> 3, k = i & 7; const float pos = idx < 2048 ? (float)idx : 8192.0f;
        const float ang = pos * rope_inv(k);
        double rev = (double)ang * 0.15915494309189535; rev -= floor(rev);
        const float rf = (float)rev;
        rope[idx * 16 + k] = __builtin_amdgcn_cosf(rf); rope[idx * 16 + 8 + k] = __builtin_amdgcn_sinf(rf);
    }
    for (int i = gt; i < 2 * 128 * 127 * 64; i += NGT) {
        const int which = i >= 128 * 127 * 64; const int r = which ? i - 128 * 127 * 64 : i;
        const int b = r / (127 * 64), rem = r % (127 * 64), j = rem >> 6, q = rem & 63;
        const float* src = (which ? P->cache_v : P->cache_k) + ((size_t)(b * 128 + j + 1)) * 256 + 4 * q;
        float* dst = P->out + (which ? OUT_VS : OUT_KS) + ((size_t)(b * 128 + j)) * 256 + 4 * q;
        *(f32x4*)dst = *(const f32x4*)src;
    }
}

__device__ __forceinline__ void attn_prompt(LAS unsigned char* lds, const bf16_t* Qb, const bf16_t* Kb, const bf16_t* Vb, const bf16_t* Gb, const float* sinks, bf16_t* OG, int G, int bid, int tid, int wave, int lane) {
    LAS bf16_t* Kl = (LAS bf16_t*)lds;
    LAS bf16_t* Vl = Kl + 256 * 72;
    const int fr = lane & 15, fq = lane >> 4;
    for (int unit = bid; unit < 512; unit += G) {
        const int kvh = unit & 3, nb = (unit >> 2) & 15, b = unit >> 6;
        __syncthreads();
#pragma unroll
        for (int i = 0; i < 4; ++i) {
            const int c = tid + 512 * i, row = c >> 3, ch = c & 7, pos = 128 * nb - 128 + row;
            u32x4 kx = {0u, 0u, 0u, 0u}, vx = {0u, 0u, 0u, 0u};
            if (pos >= 0) { const size_t off = ((size_t)(b * 2048 + pos)) * 256 + kvh * 64 + ch * 8; kx = *(const u32x4*)(Kb + off); vx = *(const u32x4*)(Vb + off); }
            *(LAS u32x4*)(Kl + row * 72 + ch * 8) = kx;
            LAS bf16_t* vd = Vl + (ch * 8) * 264 + row;
            vd[0 * 264] = (bf16_t)(vx.x & 0xffffu); vd[1 * 264] = (bf16_t)(vx.x >> 16); vd[2 * 264] = (bf16_t)(vx.y & 0xffffu); vd[3 * 264] = (bf16_t)(vx.y >> 16);
            vd[4 * 264] = (bf16_t)(vx.z & 0xffffu); vd[5 * 264] = (bf16_t)(vx.z >> 16); vd[6 * 264] = (bf16_t)(vx.w & 0xffffu); vd[7 * 264] = (bf16_t)(vx.w >> 16);
        }
        __syncthreads();
        const int qt = wave;
        const size_t qrow = (size_t)(b * 2048 + 128 * nb + 16 * qt + fr);
        for (int hq = 0; hq < 4; ++hq) {
            const int head = 4 * kvh + hq;
            const bf16x8 q0 = *(const bf16x8*)(Qb + qrow * DM + head * 64 + 8 * fq), q1 = *(const bf16x8*)(Qb + qrow * DM + head * 64 + 32 + 8 * fq);
            f32x4 S[9];
#pragma unroll
            for (int t = 0; t < 9; ++t) {
                const LAS bf16_t* kp = Kl + (16 * (qt + t) + fr) * 72 + 8 * fq;
                const bf16x8 a0 = *(const LAS bf16x8*)kp, a1 = *(const LAS bf16x8*)(kp + 32);
                f32x4 s = {0.f, 0.f, 0.f, 0.f};
                s = __builtin_amdgcn_mfma_f32_16x16x32_bf16(a0, q0, s, 0, 0, 0);
                s = __builtin_amdgcn_mfma_f32_16x16x32_bf16(a1, q1, s, 0, 0, 0);
                S[t] = s;
            }
            const float sink = sinks[head];
            float mx = sink;
#pragma unroll
            for (int t = 0; t < 9; ++t)
#pragma unroll
                for (int e = 0; e < 4; ++e) {
                    const int dl = 16 * t + 4 * fq + e - fr, j = 16 * (qt + t) + 4 * fq + e;
                    const bool ok = dl >= 0 && dl <= 128 && (nb > 0 || j >= 128);
                    S[t][e] = ok ? S[t][e] : -INFINITY;
                    mx = fmaxf(mx, S[t][e]);
                }
            mx = fmaxf(mx, __shfl_xor(mx, 16)); mx = fmaxf(mx, __shfl_xor(mx, 32));
            float sum = 0.f;
#pragma unroll
            for (int t = 0; t < 9; ++t)
#pragma unroll
                for (int e = 0; e < 4; ++e) { const float p = __expf(S[t][e] - mx); S[t][e] = p; sum += p; }
            sum += __shfl_xor(sum, 16); sum += __shfl_xor(sum, 32);
            const float inv = 1.0f / (sum + __expf(sink - mx));
            f32x4 O[4];
#pragma unroll
            for (int dt = 0; dt < 4; ++dt) O[dt] = (f32x4){0.f, 0.f, 0.f, 0.f};
#pragma unroll
            for (int tp = 0; tp < 5; ++tp) {
                const int ta = 2 * tp, tb = 2 * tp + 1 < 9 ? 2 * tp + 1 : 8;
                const f32x4 pa = S[ta], pb = (2 * tp + 1 < 9) ? S[tb] : (f32x4){0.f, 0.f, 0.f, 0.f};
                const bf16x8 bfv = __builtin_bit_cast(bf16x8, pack8(pa, pb));
#pragma unroll
                for (int dt = 0; dt < 4; ++dt) {
                    const LAS bf16_t* vp = Vl + (16 * dt + fr) * 264 + 4 * fq;
                    u32x4 av; const u32x2 lo = *(const LAS u32x2*)(vp + 16 * (qt + ta)), hi = *(const LAS u32x2*)(vp + 16 * (qt + tb));
                    av.x = lo.x; av.y = lo.y; av.z = hi.x; av.w = hi.y;
                    O[dt] = __builtin_amdgcn_mfma_f32_16x16x32_bf16(__builtin_bit_cast(bf16x8, av), bfv, O[dt], 0, 0, 0);
                }
            }
#pragma unroll
            for (int dt = 0; dt < 4; ++dt) {
                const size_t off = qrow * DM + head * 64 + 16 * dt + 4 * fq;
                const u32x2 gg = *(const u32x2*)(Gb + off);
                u32x2 o;
                o.x = pk2(O[dt][0] * inv * __uint_as_float(gg.x << 16), O[dt][1] * inv * __uint_as_float(gg.x & 0xffff0000u));
                o.y = pk2(O[dt][2] * inv * __uint_as_float(gg.y << 16), O[dt][3] * inv * __uint_as_float(gg.y & 0xffff0000u));
                *(u32x2*)(OG + off) = o;
            }
        }
    }
}

__device__ __forceinline__ void attn_sample(const float* cache_k, const float* cache_v, const float* sinks_b, float* out, const float* KVQGS, const float* rope, bf16_t* OG, int gw, int NGW, int lane) {
    for (int task = gw; task < 512; task += NGW) {
        const int b = task >> 2, kvh = task & 3;
        const float* rowp = KVQGS + (size_t)b * 2560;
        const float* rp = rope + 2048 * 16;
        const float cs = rp[lane & 7], sn = rp[8 + (lane & 7)];
        float q[4];
#pragma unroll
        for (int hq = 0; hq < 4; ++hq) {
            float x = rowp[512 + (4 * kvh + hq) * 64 + lane]; const float pr = __shfl_xor(x, 8);
            if (lane < 8) x = x * cs - pr * sn; else if (lane < 16) x = x * cs + pr * sn;
            q[hq] = x * 0.125f;
        }
        float kn = rowp[kvh * 64 + lane]; { const float pr = __shfl_xor(kn, 8); if (lane < 8) kn = kn * cs - pr * sn; else if (lane < 16) kn = kn * cs + pr * sn; }
        const float vn = rowp[256 + kvh * 64 + lane];
        out[OUT_KS + ((size_t)(b * 128 + 127)) * 256 + kvh * 64 + lane] = kn;
        out[OUT_VS + ((size_t)(b * 128 + 127)) * 256 + kvh * 64 + lane] = vn;
        const float* k0p = cache_k + ((size_t)(b * 128 + lane)) * 256 + kvh * 64;
        const float* k1p = k0p + 64 * 256;
        float s0[4] = {0.f, 0.f, 0.f, 0.f}, s1[4] = {0.f, 0.f, 0.f, 0.f};
#pragma unroll
        for (int d4 = 0; d4 < 16; ++d4) {
            const f32x4 ka = *(const f32x4*)(k0p + 4 * d4), kb = *(const f32x4*)(k1p + 4 * d4);
#pragma unroll
            for (int c = 0; c < 4; ++c)
#pragma unroll
                for (int hq = 0; hq < 4; ++hq) { const float qd = __int_as_float(__builtin_amdgcn_readlane(__float_as_int(q[hq]), 4 * d4 + c)); s0[hq] += qd * ka[c]; s1[hq] += qd * kb[c]; }
        }
        float o[4];
#pragma unroll
        for (int hq = 0; hq < 4; ++hq) {
            const float snew = wave_sum(q[hq] * kn), sink = sinks_b[4 * kvh + hq];
            const float mx = fmaxf(fmaxf(wave_max(fmaxf(s0[hq], s1[hq])), snew), sink);
            const float p0 = __expf(s0[hq] - mx), p1 = __expf(s1[hq] - mx), pn = __expf(snew - mx);
            const float den = wave_sum(p0 + p1) + pn + __expf(sink - mx);
            s0[hq] = p0 / den; s1[hq] = p1 / den; o[hq] = (pn / den) * vn;
        }
        const float* vp = cache_v + ((size_t)(b * 128)) * 256 + kvh * 64 + lane;
#pragma unroll 8
        for (int key = 0; key < 64; ++key) {
            const float va = vp[(size_t)key * 256], vb = vp[(size_t)(key + 64) * 256];
#pragma unroll
            for (int hq = 0; hq < 4; ++hq) {
                o[hq] += __int_as_float(__builtin_amdgcn_readlane(__float_as_int(s0[hq]), key)) * va;
                o[hq] += __int_as_float(__builtin_amdgcn_readlane(__float_as_int(s1[hq]), key)) * vb;
            }
        }
#pragma unroll
        for (int hq = 0; hq < 4; ++hq) {
            const int col = (4 * kvh + hq) * 64 + lane;
            const float gt = silu(rowp[1536 + col]);
            const unsigned w = pk2(o[hq] * gt, 0.f);
            OG[(size_t)(TP + b) * DM + col] = (bf16_t)(w & 0xffffu);
        }
    }
}


#ifndef REP0
#define REP0 1
#endif
#ifndef REP1
#define REP1 1
#endif
#ifndef REP2
#define REP2 1
#endif
#ifndef REP3
#define REP3 1
#endif
#ifndef REP4
#define REP4 1
#endif
#ifndef REP5
#define REP5 1
#endif
#ifndef REP6
#define REP6 1
#endif
#ifndef REP7
#define REP7 1
#endif
#ifndef REPS
#define REPS 1
#endif
#define GSYNC() do { for (int r_ = 0; r_ < REPS; ++r_) { ArgP A_ = args_ptr(); xcd_barrier((unsigned*)(A_->ws + WS_SMALL) + BAR_F32_IDX, bst); } } while (0)
constexpr size_t WS_DUMMY = WS_END;

#define XB_TMO      128
#define XB_XCNT(j)  (256  + 64 * (j))
#define XB_XSUB(j)  (1280 + 64 * (j))
#define XB_XGEN(j)  (2304 + 64 * (j))
#define XB_TOP      3328
#define XB_TOPGEN   3392
#define XCD_BAR_WORDS 3456
#define XB_SPIN_CAP (1u << 18)
__device__ __forceinline__ unsigned xb_ld(unsigned* p)              { return __hip_atomic_load(p, __ATOMIC_RELAXED, __HIP_MEMORY_SCOPE_AGENT); }
__device__ __forceinline__ unsigned xb_add(unsigned* p, unsigned v) { return __hip_atomic_fetch_add(p, v, __ATOMIC_RELAXED, __HIP_MEMORY_SCOPE_AGENT); }
__device__ __forceinline__ unsigned xb_xcc_id() { return (unsigned)__builtin_amdgcn_s_getreg((3 << 11) | 20) & 0xFu; }
#define XB_SPIN(cond, bar) do { unsigned _sp = 0; while (cond) { __builtin_amdgcn_s_sleep(1); \
    if ((++_sp & 255u) == 0u) { if (xb_ld(&(bar)[XB_TMO])) break; if (_sp > XB_SPIN_CAP) { atomicAdd(&(bar)[XB_TMO], 1u); break; } } } } while (0)
__device__ __forceinline__ void xcd_barrier_complete(unsigned* bar, unsigned x, unsigned& nloc, unsigned& nx) {
    const unsigned G = gridDim.x * gridDim.y * gridDim.z;
    unsigned sum, cnt, mine, sp = 0u;
    for (;;) {
        sum = 0u; cnt = 0u; mine = 0u;
#pragma unroll
        for (unsigned j = 0; j < 16; ++j) { const unsigned c = xb_ld(&bar[XB_XCNT(j)]); sum += c; cnt += (c > 0u) ? 1u : 0u; mine = (j == x) ? c : mine; }
        if (sum == G) break;
        __builtin_amdgcn_s_sleep(1);
        if ((++sp & 255u) == 0u) { if (xb_ld(&bar[XB_TMO])) break; if (sp > XB_SPIN_CAP) { atomicAdd(&bar[XB_TMO], 1u); break; } }
    }
    nloc = mine > 0u ? mine : 1u; nx = cnt > 0u ? cnt : 1u;
}
__device__ __forceinline__ void xcd_barrier(unsigned* bar, volatile LAS unsigned* st) {
    asm volatile("s_waitcnt vmcnt(0)" ::: "memory");
    __syncthreads();
    if (threadIdx.x == 0) {
        const unsigned x = xb_xcc_id();
        __builtin_amdgcn_s_waitcnt(0);
        unsigned nloc = st[0], nx = st[1];
        if (nloc == 0u) { xcd_barrier_complete(bar, x, nloc, nx); st[0] = nloc; st[1] = nx; }
        const unsigned old = xb_add(&bar[XB_XSUB(x)], 1u);
        const unsigned gen = old / nloc;
        if (old + 1u == (gen + 1u) * nloc) {
            __builtin_amdgcn_fence(__ATOMIC_RELEASE, "agent");
            asm volatile("s_waitcnt vmcnt(0)" ::: "memory");
            const unsigned og = xb_add(&bar[XB_TOP], 1u);
            const unsigned tg = og / nx;
            if (og + 1u == (tg + 1u) * nx) xb_add(&bar[XB_TOPGEN], 1u);
            else XB_SPIN(xb_ld(&bar[XB_TOPGEN]) == tg, bar);
            __builtin_amdgcn_fence(__ATOMIC_ACQUIRE, "agent");
            xb_add(&bar[XB_XGEN(x)], 1u);
            asm volatile("s_waitcnt vmcnt(0)" ::: "memory");
        } else {
            XB_SPIN(xb_ld(&bar[XB_XGEN(x)]) == gen, bar);
            __builtin_amdgcn_fence(__ATOMIC_ACQUIRE, "agent");
            asm volatile("s_waitcnt vmcnt(0)" ::: "memory");
        }
    }
    __syncthreads();
}
constexpr int BAR_F32_IDX = 200704;
__device__ __forceinline__ ArgP args_ptr() { ArgP p = (ArgP)__builtin_amdgcn_kernarg_segment_ptr(); asm volatile("" : "+s"(p)); return p; }
#define WSP(T, off) ((T*)(ws + (off)))
#define SMALLF(i) (WSP(float, WS_SMALL) + (i) * 32768)

__global__ void __launch_bounds__(512, 2) yoco_fwd(Params Pin) {
    extern __shared__ __attribute__((aligned(16))) unsigned char lds_raw[];
    LAS unsigned char* lds = (LAS unsigned char*)lds_raw;
    cg::grid_group grid = cg::this_grid();
    const int tid0 = threadIdx.x, wave = __builtin_amdgcn_readfirstlane(tid0 >> 6);
#define PH_IDS int tid = tid0; asm volatile("" : "+v"(tid)); const int lane = tid & 63; (void)lane
    const int G = gridDim.x, bid = blockIdx.x, gw = bid * NWV + wave, NGW = G * NWV;
    volatile LAS unsigned* bst = (volatile LAS unsigned*)(lds + pg8::STAGE_BYTES);
    { ArgP A_ = args_ptr(); unsigned char* ws_ = A_->ws; unsigned* bar = (unsigned*)(ws_ + WS_SMALL) + BAR_F32_IDX;
      if (ws_ == nullptr) grid.sync();
      if (tid0 == 0) { bst[0] = 0u; bst[1] = 0u; (void)xb_add(&bar[XB_XCNT(xb_xcc_id())], 1u); } }
    __syncthreads();

    for (int rep = 0; rep < REP0; ++rep) { PH_IDS; ArgP A = args_ptr(); prologue(A, lds, gw, NGW, wave, lane); }
    GSYNC();

    for (int rep = 0; rep < REP1; ++rep) {
        PH_IDS; ArgP A = args_ptr(); unsigned char* ws = A->ws;
        pg8::Gemm g{WSP(bf16_t, WS_W1), WSP(bf16_t, WS_XN), AW, TP, DM}; pg8::StaticOrder S; S.init(AW, TP, G, bid);
        EpiVT E{WSP(bf16_t, WS_VT), rep == 0 ? SMALLF(0) : SMALLF(5)};
        pg8::gemm_phase<EpiVT, pg8::StaticOrder, true, true>(lds, g, S, E);
    }
    for (int rep = 0; rep < REP1; ++rep) {
        PH_IDS; ArgP A = args_ptr(); unsigned char* ws = A->ws; float* UVGS = WSP(float, WS_UVGS);
        mini_gemm(WSP(bf16_t, WS_XN) + (size_t)TP * DM, WSP(bf16_t, WS_W1), DM, 6144, gw, NGW, lane, [=](int row, int n, f32x4 v) {
            int ty, ch; if (n < 2048) { ty = 1; ch = n; } else { const int t = (n - 2048) >> 8, w = (n - 2048) & 255; if (w < 128) { ty = 0; ch = 128 * t + w; } else { ty = 2; ch = 128 * t + w - 128; } }
            *(f32x4*)(UVGS + ((size_t)row * 3 + ty) * AW + ch) = v; });
    }

#ifdef XK
    for (int rep = 0; rep < XK; ++rep) {
        PH_IDS; ArgP A = args_ptr(); unsigned char* ws = A->ws;
        pg8::Gemm g{WSP(bf16_t, WS_W1), WSP(bf16_t, WS_XN), AW, TP, DM}; pg8::StaticOrder S; S.init(AW, TP, G, bid);
        EpiNull E{WSP(float, WS_DUMMY)};
        pg8::gemm_phase<EpiNull, pg8::StaticOrder, true, true>(lds, g, S, E);
    }
#endif
#ifdef XM
    for (int rep = 0; rep < XM; ++rep) {
        PH_IDS; ArgP A = args_ptr(); unsigned char* ws = A->ws; float* DUM = WSP(float, WS_DUMMY);
        mini_gemm(WSP(bf16_t, WS_XN) + (size_t)TP * DM, WSP(bf16_t, WS_W1), DM, 6144, gw, NGW, lane, [=](int row, int n, f32x4 v) {
            *(f32x4*)(DUM + ((size_t)row * 6144) + n) = v; });
    }
#endif
    GSYNC();

    for (int rep = 0; rep < REP2; ++rep) {
        PH_IDS; ArgP A = args_ptr(); unsigned char* ws = A->ws;
        pg8::Gemm g{WSP(bf16_t, WS_XN), WSP(bf16_t, WS_W1) + (size_t)2048 * DM, TP, 4096, DM}; pg8::StaticOrder S; S.init(TP, 4096, G, bid);
        EpiUG E{WSP(bf16_t, WS_VT), SMALLF(0), A->w_s_a, A->b_s_a, A->v_norm_a, WSP(bf16_t, WS_Y)};
        pg8::gemm_phase<EpiUG, pg8::StaticOrder, true, true>(lds, g, S, E);
    }
    {
        PH_IDS; ArgP A = args_ptr(); unsigned char* ws = A->ws; const float* UVGS = WSP(float, WS_UVGS); bf16_t* Y = WSP(bf16_t, WS_Y);
        const float* v_norm = A->v_norm_a; const float* w_s = A->w_s_a; const float* b_s = A->b_s_a; float* out = A->out;
        for (int b = gw; b < TS; b += NGW) {
            const float* ur = UVGS + (size_t)b * 3 * AW; const float* vr = ur + AW; const float* gr = ur + 2 * AW;
            f32x4 vv[8]; float s = 0.f;
#pragma unroll
            for (int i = 0; i < 8; ++i) { vv[i] = *(const f32x4*)(vr + 4 * (lane + 64 * i)); s += (vv[i][0] * vv[i][0] + vv[i][1] * vv[i][1]) + (vv[i][2] * vv[i][2] + vv[i][3] * vv[i][3]); }
            const float rs = rsqrtf(wave_sum(s) * (1.0f / AW) + EPS);
#pragma unroll
            for (int i = 0; i < 8; ++i) {
                const int c = 4 * (lane + 64 * i), gi = c >> 8;
                const f32x4 gvv = *(const f32x4*)(v_norm + c), uu = *(const f32x4*)(ur + c), gg = *(const f32x4*)(gr + c);
                const float w00 = w_s[(size_t)gi * 128 * 128], b0 = b_s[gi * 128];
                f32x4 vn, y;
#pragma unroll
                for (int e = 0; e < 4; ++e) { vn[e] = vv[i][e] * rs * gvv[e]; y[e] = uu[e] * (w00 * vn[e] + b0) * silu(gg[e]); }
                *(f32x4*)(out + OUT_AV + (size_t)b * AW + c) = vn;
                u32x2 o; o.x = pk2(y[0], y[1]); o.y = pk2(y[2], y[3]);
                *(u32x2*)(Y + (size_t)(TP + b) * AW + c) = o;
            }
        }
    }
    GSYNC();

    for (int rep = 0; rep < REP3; ++rep) {
        PH_IDS; ArgP A = args_ptr(); unsigned char* ws = A->ws;
        pg8::Gemm g{WSP(bf16_t, WS_Y), WSP(bf16_t, WS_W2), TP, DM, AW}; pg8::StaticOrder S; S.init(TP, DM, G, bid);
        EpiRes<true> E{A->x_prompt, A->out, WSP(bf16_t, WS_XN), rep == 0 ? SMALLF(1) : SMALLF(5)};
        pg8::gemm_phase<EpiRes<true>, pg8::StaticOrder, true, true>(lds, g, S, E);
    }
    for (int rep = 0; rep < REP3; ++rep) {
        PH_IDS; ArgP A = args_ptr(); unsigned char* ws = A->ws; const float* xs = A->x_sample; float* H = A->out; bf16_t* H1b = WSP(bf16_t, WS_XN); float* hsq = rep == 0 ? SMALLF(1) : SMALLF(5);
        mini_gemm(WSP(bf16_t, WS_Y) + (size_t)TP * AW, WSP(bf16_t, WS_W2), AW, DM, gw, NGW, lane, [=](int row, int n, f32x4 v) {
            const f32x4 h = v + *(const f32x4*)(xs + (size_t)row * DM + n);
            *(f32x4*)(H + (size_t)(TP + row) * DM + n) = h;
            u32x2 o; o.x = pk2(h[0], h[1]); o.y = pk2(h[2], h[3]); *(u32x2*)(H1b + (size_t)(TP + row) * DM + n) = o;
            float s = (h[0] * h[0] + h[1] * h[1]) + (h[2] * h[2] + h[3] * h[3]); s += __shfl_xor(s, 16); s += __shfl_xor(s, 32);
            if ((threadIdx.x & 63) < 16) unsafeAtomicAdd(hsq + TP + row, s); });
    }
    GSYNC();

    for (int rep = 0; rep < REP4; ++rep) {
        PH_IDS; ArgP A = args_ptr(); unsigned char* ws = A->ws; float* out = A->out;
        pg8::Gemm g{WSP(bf16_t, WS_XN), WSP(bf16_t, WS_W3), TP, 2560, DM}; pg8::StaticOrder S; S.init(TP, 2560, G, bid);
        Epi3 E{SMALLF(1), SMALLF(3), WSP(bf16_t, WS_Y), WSP(bf16_t, WS_Y) + (size_t)TP * 256, WSP(bf16_t, WS_VT), WSP(bf16_t, WS_VT) + (size_t)TP * DM, out + OUT_KP, out + OUT_VP};
        pg8::gemm_phase<Epi3, pg8::StaticOrder, true, true>(lds, g, S, E);
    }
    for (int rep = 0; rep < REP4; ++rep) {
        PH_IDS; ArgP A = args_ptr(); unsigned char* ws = A->ws; float* KVQGS = WSP(float, WS_KVQGS); const float* hsq = SMALLF(1);
        mini_gemm(WSP(bf16_t, WS_XN) + (size_t)TP * DM, WSP(bf16_t, WS_W3), DM, 2560, gw, NGW, lane, [=](int row, int n, f32x4 v) {
            const float rs = rsqrtf(hsq[TP + row] * (1.0f / DM) + EPS);
            *(f32x4*)(KVQGS + (size_t)row * 2560 + n) = v * rs; });
    }
    GSYNC();

    for (int rep = 0; rep < REP5; ++rep) {
        PH_IDS; ArgP A = args_ptr(); unsigned char* ws = A->ws;
        attn_prompt(lds, WSP(bf16_t, WS_VT), WSP(bf16_t, WS_Y), WSP(bf16_t, WS_Y) + (size_t)TP * 256, WSP(bf16_t, WS_VT) + (size_t)TP * DM, A->sinks_b, WSP(bf16_t, WS_XN), G, bid, tid, wave, lane);
    }
    for (int rep = 0; rep < REP5; ++rep) {
        PH_IDS; ArgP A = args_ptr(); unsigned char* ws = A->ws;
        attn_sample(A->cache_k, A->cache_v, A->sinks_b, A->out, WSP(float, WS_KVQGS), SMALLF(3), WSP(bf16_t, WS_XN), gw, NGW, lane);
    }
    GSYNC();

    for (int rep = REP6 - 1; rep >= 0; --rep) {
        PH_IDS; ArgP A = args_ptr(); unsigned char* ws = A->ws; float* H = A->out;
        pg8::Gemm g{WSP(bf16_t, WS_XN), WSP(bf16_t, WS_W4), TP, DM, DM}; pg8::StaticOrder S; S.init(TP, DM, G, bid);
        EpiRes<false> E{H, rep == 0 ? H : WSP(float, WS_DUMMY), nullptr, rep == 0 ? SMALLF(2) : SMALLF(5)};
        pg8::gemm_phase<EpiRes<false>, pg8::StaticOrder, true, true>(lds, g, S, E);
    }
    {
        PH_IDS; ArgP A = args_ptr(); unsigned char* ws = A->ws; float* H = A->out; float* h2sq = SMALLF(2);
        mini_gemm(WSP(bf16_t, WS_XN) + (size_t)TP * DM, WSP(bf16_t, WS_W4), DM, DM, gw, NGW, lane, [=](int row, int n, f32x4 v) {
            float* hp = H + (size_t)(TP + row) * DM + n;
            const f32x4 h = v + *(const f32x4*)hp; *(f32x4*)hp = h;
            float s = (h[0] * h[0] + h[1] * h[1]) + (h[2] * h[2] + h[3] * h[3]); s += __shfl_xor(s, 16); s += __shfl_xor(s, 32);
            if ((threadIdx.x & 63) < 16) unsafeAtomicAdd(h2sq + TP + row, s); });
    }
    GSYNC();

    for (int rep = REP7 - 1; rep >= 0; --rep) {
        PH_IDS; ArgP A = args_ptr(); unsigned char* ws = A->ws; float* H = A->out; const float* h2sq = SMALLF(2); const float* fnp = A->final_norm; float* HO = rep == 0 ? H : WSP(float, WS_DUMMY);
        for (int row = gw; row < TT; row += NGW) {
            const float rs = rsqrtf(h2sq[row] * (1.0f / DM) + EPS);
            const float* hp = H + (size_t)row * DM; float* ho = HO + (size_t)row * DM;
#pragma unroll
            for (int j = 0; j < 4; ++j) { const int c = 4 * lane + 256 * j; const f32x4 h = *(const f32x4*)(hp + c), fn = *(const f32x4*)(fnp + c); *(f32x4*)(ho + c) = h * rs * fn; }
        }
    }
}

extern "C" void kernel_launch(void* const* d_in, const int* in_sizes, int n_in, void* d_out, int out_size, void* d_ws, size_t ws_size, hipStream_t stream) {
    constexpr int LDS_BYTES = pg8::STAGE_BYTES + 16;
    static int grid_blocks = 0;
    if (grid_blocks == 0) {
        if (n_in != 17 || ws_size < WS_END) { fprintf(stderr, "kernel_launch: unexpected inputs (n_in %d, ws %zu)\n", n_in, ws_size); grid_blocks = -1; return; }
        int dev = 0, cus = 0, per_cu = 0;
        hipGetDevice(&dev); hipDeviceGetAttribute(&cus, hipDeviceAttributeMultiprocessorCount, dev);
        if (hipFuncSetAttribute((const void*)yoco_fwd, hipFuncAttributeMaxDynamicSharedMemorySize, LDS_BYTES) != hipSuccess) { fprintf(stderr, "kernel_launch: hipFuncSetAttribute failed\n"); grid_blocks = -1; return; }
        if (hipOccupancyMaxActiveBlocksPerMultiprocessor(&per_cu, (const void*)yoco_fwd, 512, LDS_BYTES) != hipSuccess || per_cu < 1) { fprintf(stderr, "kernel_launch: occupancy query says %d blocks per CU\n", per_cu); per_cu = 1; }
        (void)hipGetLastError();
        grid_blocks = cus;
    }
    if (grid_blocks < 0) return;
    Params p{};
    p.x_prompt = (const float*)d_in[0]; p.x_sample = (const float*)d_in[1]; p.cache_k = (const float*)d_in[2]; p.cache_v = (const float*)d_in[3];
    p.norm_a = (const float*)d_in[4]; p.w_in_a = (const float*)d_in[5]; p.v_norm_a = (const float*)d_in[6]; p.w_s_a = (const float*)d_in[7]; p.b_s_a = (const float*)d_in[8];
    p.w_out_a = (const float*)d_in[9]; p.kv_norm = (const float*)d_in[10]; p.w_kv = (const float*)d_in[11]; p.norm_b = (const float*)d_in[12]; p.w_in_b = (const float*)d_in[13];
    p.sinks_b = (const float*)d_in[14]; p.w_out_b = (const float*)d_in[15]; p.final_norm = (const float*)d_in[16];
    p.out = (float*)d_out; p.ws = (unsigned char*)d_ws;
    if (hipMemsetAsync((unsigned char*)d_ws + WS_SMALL + (size_t)BAR_F32_IDX * 4, 0, XCD_BAR_WORDS * 4, stream) != hipSuccess) { fprintf(stderr, "kernel_launch: memset of the barrier words failed\n"); return; }
    void* args[] = {&p};
    hipError_t e = hipLaunchCooperativeKernel((const void*)yoco_fwd, dim3(grid_blocks), dim3(512), args, LDS_BYTES, stream);
    if (e != hipSuccess) fprintf(stderr, "kernel_launch: cooperative launch failed: %s (grid %d)\n", hipGetErrorString(e), grid_blocks);
}
```

```cpp
#include <hip/hip_runtime.h>
#include <hip/hip_cooperative_groups.h>
#include <cstdio>
#include <cstdint>
namespace cg = cooperative_groups;
namespace pg8 {
#define PG8_LAS __attribute__((address_space(3)))
typedef unsigned short bf16_t;
typedef short bf16x8 __attribute__((ext_vector_type(8)));
typedef float f32x4 __attribute__((ext_vector_type(4)));
typedef unsigned u32x4 __attribute__((ext_vector_type(4)));
constexpr int BM = 256, BK = 64, HALF = 128, HTB = HALF * BK * 2  , STAGE_BYTES = 8 * HTB, NXCD = 8, WGM = 8;

__host__ __device__ __forceinline__ int lds_byte(int r, int c) { const int st = (r >> 4) * 2 + (c >> 5), rr = r & 15, cc = c & 31, ob = rr * 64 + cc * 2; return st * 1024 + (ob ^ (((ob >> 9) & 1) << 5)); }
__host__ __device__ __forceinline__ void stage_rc(int b, int& R, int& C) { const int st = b / 1024, sb = b % 1024, swz = sb ^ (((sb >> 9) & 1) << 5); R = (st >> 1) * 16 + swz / 64; C = (st & 1) * 32 + (swz % 64) / 2; }
__host__ __device__ __forceinline__ int perm32(int rho) { const int n = rho >> 4, i = rho & 15; return 8 * (i >> 2) + 4 * n + (i & 3); }

struct Unit { int pm, pn; };
struct Gemm { const bf16_t* A; const bf16_t* Bt; int M, N, K; };

struct StaticOrder {
    int nM, nN, nwg, G, c;
    __host__ __device__ void init(int M, int N, int G_, int c_) { nM = M / BM; nN = N / BM; nwg = nM * nN; G = G_; c = c_; }
    __host__ __device__ bool next(int i, Unit& u) const {
        const long L = (long)i * G + c; if (L >= nwg) return false;
        int wgid = (int)L; { const int q = nwg / NXCD, r = nwg % NXCD, xcd = wgid % NXCD, off = wgid / NXCD; wgid = (xcd < r ? xcd * (q + 1) : r * (q + 1) + (xcd - r) * q) + off; }
        const int nig = WGM * nN, gid = wgid / nig, fm = gid * WGM, gsz = (nM - fm) < WGM ? (nM - fm) : WGM;
        u.pm = fm + ((wgid % nig) % gsz); u.pn = (wgid % nig) / gsz; return true;
    }
    __device__ __forceinline__ void a_ready(const Unit&) const {}
    __device__ __forceinline__ void done(const Unit&) const {}
};
__device__ __forceinline__ unsigned cvt_pk_bf16(float lo, float hi) { unsigned r; asm volatile("v_cvt_pk_bf16_f32 %0, %1, %2" : "=v"(r) : "v"(lo), "v"(hi)); return r; }
template <class Epi, class Sched, bool ALIGN_EPI = false, bool SP2 = false>
__device__ __forceinline__ void gemm_phase(PG8_LAS unsigned char* lds, const Gemm g, const Sched& S, const Epi& E) {
    const int tid = threadIdx.x, wid = __builtin_amdgcn_readfirstlane(tid >> 6), lane = tid & 63, wr = wid >> 2, wc = wid & 3, fr = lane & 15, fq = lane >> 4;
    const int K = g.K, nt = K / BK;
    unsigned voffA[2], voffB[2];
#pragma unroll
    for (int i = 0; i < 2; ++i) { int R, C; stage_rc(tid * 16 + i * 8192, R, C); const int Rb = Epi::PERM ? ((R & ~31) + perm32(R & 31)) : R;
        voffA[i] = (unsigned)(R * K + C) * 2u; voffB[i] = (unsigned)(Rb * K + C) * 2u; }
    const size_t kstep = (size_t)(BK * 2);
    const size_t hstep = (size_t)HALF * K * 2;
    const size_t tstep = 2 * hstep;
    const unsigned ldsw = (unsigned)wid * 1024u;
    const int aoff = lds_byte(wr * 64 + fr, fq * 8), boff = lds_byte(wc * 32 + fr, fq * 8);
#define PG8_SA(b, h) (((b) * 2 + (h)) * HTB)
#define PG8_SB(b, h) ((4 + (b) * 2 + (h)) * HTB)
#define PG8_STAGE(bufoff, gbase, voff) do { _Pragma("unroll") for (int _i = 0; _i < 2; ++_i) \
        __builtin_amdgcn_global_load_lds((const unsigned*)((const char*)(gbase) + (voff)[_i]), (PG8_LAS unsigned*)(lds + (bufoff) + ldsw + _i * 8192), 16, 0, 0); } while (0)
#define PG8_LDA(dst, b, h) do { _Pragma("unroll") for (int m = 0; m < 4; ++m) _Pragma("unroll") for (int k = 0; k < 2; ++k) dst[m][k] = *(const PG8_LAS bf16x8*)(lds + PG8_SA(b, h) + aoff + m * 2048 + k * 1024); } while (0)
#define PG8_LDB(dst, b, h) do { _Pragma("unroll") for (int n = 0; n < 2; ++n) _Pragma("unroll") for (int k = 0; k < 2; ++k) dst[n][k] = *(const PG8_LAS bf16x8*)(lds + PG8_SB(b, h) + boff + n * 2048 + k * 1024); } while (0)
#define PG8_MMA(ai, bj, At, Bt) do { __builtin_amdgcn_s_setprio(1); _Pragma("unroll") for (int m = 0; m < 4; ++m) _Pragma("unroll") for (int n = 0; n < 2; ++n) _Pragma("unroll") for (int k = 0; k < 2; ++k) \
        acc[ai][bj][m][n] = __builtin_amdgcn_mfma_f32_16x16x32_bf16(Bt[n][k], At[m][k], acc[ai][bj][m][n], 0, 0, 0); __builtin_amdgcn_s_setprio(0); } while (0)
#define PG8_WAIT_V(n) asm volatile("s_waitcnt vmcnt(" #n ")" ::: "memory")
#define PG8_WAIT_L(n) asm volatile("s_waitcnt lgkmcnt(" #n ")" ::: "memory")
#define PG8_BAR __builtin_amdgcn_s_barrier()
#define PG8_SCHED __builtin_amdgcn_sched_barrier(0)
    Unit cur, nxt; int ui = 0;
    if (!S.next(0, cur)) return;
    f32x4 acc[2][2][4][2];
#pragma unroll
    for (int a = 0; a < 2; ++a)
#pragma unroll
        for (int b = 0; b < 2; ++b)
#pragma unroll
            for (int m = 0; m < 4; ++m)
#pragma unroll
                for (int n = 0; n < 2; ++n) acc[a][b][m][n] = (f32x4){0.f, 0.f, 0.f, 0.f};
    bf16x8 At[4][2], B0[2][2], B1[2][2];
    const char* cA = (const char*)g.A + (size_t)cur.pm * tstep; const char* cB = (const char*)g.Bt + (size_t)cur.pn * tstep;
    S.a_ready(cur);
    if constexpr (SP2) {
        PG8_STAGE(PG8_SB(0, 0), cB, voffB); PG8_STAGE(PG8_SB(0, 1), cB + hstep, voffB); PG8_STAGE(PG8_SA(0, 0), cA, voffA); PG8_STAGE(PG8_SA(0, 1), cA + hstep, voffA);
        if (wr == 1) PG8_BAR;
        PG8_WAIT_V(2); PG8_BAR;
        PG8_STAGE(PG8_SB(1, 0), cB + kstep, voffB); PG8_STAGE(PG8_SA(1, 0), cA + kstep, voffA); PG8_STAGE(PG8_SB(1, 1), cB + hstep + kstep, voffB);
        PG8_WAIT_V(6); PG8_BAR;
    } else {
        PG8_STAGE(PG8_SB(0, 0), cB, voffB); PG8_STAGE(PG8_SA(0, 0), cA, voffA); PG8_STAGE(PG8_SB(0, 1), cB + hstep, voffB); PG8_STAGE(PG8_SA(0, 1), cA + hstep, voffA);
        if (wr == 1) PG8_BAR;
        PG8_WAIT_V(4); PG8_BAR;
        PG8_STAGE(PG8_SB(1, 0), cB + kstep, voffB); PG8_STAGE(PG8_SA(1, 0), cA + kstep, voffA); PG8_STAGE(PG8_SB(1, 1), cB + hstep + kstep, voffB);
        PG8_WAIT_V(6); PG8_BAR;
    }
    for (;;) {
        const bool has_next = S.next(ui + 1, nxt);
        const char* nA = has_next ? (const char*)g.A + (size_t)nxt.pm * tstep : cA; const char* nB = has_next ? (const char*)g.Bt + (size_t)nxt.pn * tstep : cB;
        for (int t = 0; t < nt; t += 2) {
            const bool last = (t == nt - 2);
            const char* a1 = cA + (size_t)(t + 1) * kstep;
            const char* a2 = last ? nA : cA + (size_t)(t + 2) * kstep; const char* b2 = last ? nB : cB + (size_t)(t + 2) * kstep;
            const char* a3 = a2 + kstep; const char* b3 = b2 + kstep;
            if (last && has_next) S.a_ready(nxt);
            if constexpr (SP2) {
            PG8_LDB(B0, 0, 0); PG8_LDB(B1, 0, 1); PG8_SCHED; PG8_LDA(At, 0, 0); PG8_STAGE(PG8_SA(1, 1), a1 + hstep, voffA);
            PG8_WAIT_V(8); PG8_WAIT_L(0); PG8_BAR; PG8_MMA(0, 0, At, B0); PG8_MMA(0, 1, At, B1); PG8_BAR; PG8_SCHED;
            PG8_LDA(At, 0, 1); PG8_STAGE(PG8_SB(0, 0), b2, voffB); PG8_STAGE(PG8_SB(0, 1), b2 + hstep, voffB); PG8_STAGE(PG8_SA(0, 0), a2, voffA);
            PG8_WAIT_V(8); PG8_WAIT_L(0); PG8_BAR; PG8_MMA(1, 0, At, B0); PG8_MMA(1, 1, At, B1); PG8_BAR; PG8_SCHED;
            PG8_LDB(B0, 1, 0); PG8_LDB(B1, 1, 1); PG8_SCHED; PG8_LDA(At, 1, 0); PG8_STAGE(PG8_SA(0, 1), a2 + hstep, voffA);
            PG8_WAIT_V(8); PG8_WAIT_L(0); PG8_BAR; PG8_MMA(0, 0, At, B0); PG8_MMA(0, 1, At, B1); PG8_BAR; PG8_SCHED;
            PG8_LDA(At, 1, 1); PG8_STAGE(PG8_SB(1, 0), b3, voffB); PG8_STAGE(PG8_SB(1, 1), b3 + hstep, voffB); PG8_STAGE(PG8_SA(1, 0), a3, voffA);
            PG8_WAIT_V(8); PG8_WAIT_L(0); PG8_BAR; PG8_MMA(1, 0, At, B0); PG8_MMA(1, 1, At, B1); PG8_BAR; PG8_SCHED;
            } else {
            PG8_LDB(B0, 0, 0); PG8_SCHED; PG8_LDA(At, 0, 0); PG8_STAGE(PG8_SA(1, 1), a1 + hstep, voffA);
            PG8_WAIT_L(8); PG8_BAR; PG8_WAIT_L(0); PG8_MMA(0, 0, At, B0); PG8_BAR; PG8_SCHED;
            PG8_LDB(B1, 0, 1); PG8_STAGE(PG8_SB(0, 0), b2, voffB);
            PG8_BAR; PG8_WAIT_L(0); PG8_MMA(0, 1, At, B1); PG8_BAR;
            PG8_LDA(At, 0, 1); PG8_STAGE(PG8_SA(0, 0), a2, voffA);
            PG8_BAR; PG8_WAIT_L(0); PG8_MMA(1, 0, At, B0); PG8_BAR; PG8_SCHED;
            PG8_STAGE(PG8_SB(0, 1), b2 + hstep, voffB);
            PG8_WAIT_V(6); PG8_BAR; PG8_MMA(1, 1, At, B1); PG8_BAR;
            PG8_LDB(B0, 1, 0); PG8_SCHED; PG8_LDA(At, 1, 0); PG8_STAGE(PG8_SA(0, 1), a2 + hstep, voffA);
            PG8_WAIT_L(8); PG8_BAR; PG8_WAIT_L(0); PG8_MMA(0, 0, At, B0); PG8_BAR; PG8_SCHED;
            PG8_LDB(B1, 1, 1); PG8_STAGE(PG8_SB(1, 0), b3, voffB);
            PG8_BAR; PG8_WAIT_L(0); PG8_MMA(0, 1, At, B1); PG8_BAR;
            PG8_LDA(At, 1, 1); PG8_STAGE(PG8_SA(1, 0), a3, voffA);
            PG8_BAR; PG8_WAIT_L(0); PG8_MMA(1, 0, At, B0); PG8_BAR; PG8_SCHED;
            PG8_STAGE(PG8_SB(1, 1), b3 + hstep, voffB);
            PG8_WAIT_V(6); PG8_BAR; PG8_MMA(1, 1, At, B1); PG8_BAR;
            }
        }
        if constexpr (ALIGN_EPI) { if (wr == 0) PG8_BAR; }
        if constexpr (!Epi::AFTER_DRAIN) { E(acc, cur, wr, wc, fr, fq); S.done(cur); }
        if (!has_next) break;
#pragma unroll
        for (int a = 0; a < 2; ++a)
#pragma unroll
            for (int b = 0; b < 2; ++b)
#pragma unroll
                for (int m = 0; m < 4; ++m)
#pragma unroll
                    for (int n = 0; n < 2; ++n) acc[a][b][m][n] = (f32x4){0.f, 0.f, 0.f, 0.f};
        cur = nxt; cA = nA; cB = nB; ++ui;
        if constexpr (ALIGN_EPI) { if (wr == 1) PG8_BAR; }
    }
    PG8_WAIT_V(0);
    if constexpr (!ALIGN_EPI) { if (wr == 0) PG8_BAR; }
    PG8_BAR;
    if constexpr (Epi::AFTER_DRAIN) { E.fused(acc, cur, wr, wc, fr, fq, lds, wid, lane); S.done(cur); }
#undef PG8_SA
#undef PG8_SB
#undef PG8_STAGE
#undef PG8_LDA
#undef PG8_LDB
#undef PG8_MMA
#undef PG8_WAIT_V
#undef PG8_WAIT_L
#undef PG8_BAR
#undef PG8_SCHED
}
}

#define LAS __attribute__((address_space(3)))
using pg8::bf16_t; using pg8::bf16x8; using pg8::f32x4; using pg8::u32x4; using pg8::Unit;
typedef unsigned u32x2 __attribute__((ext_vector_type(2)));
constexpr int DM = 1024, TP = 16384, TS = 128, TT = TP + TS, AW = 2048, NWV = 8;
constexpr float EPS = 1e-5f;
constexpr size_t MiB = 1u << 20;
constexpr size_t WS_W1 = 0, WS_W2 = 12 * MiB, WS_W3 = 16 * MiB, WS_W4 = 21 * MiB, WS_SMALL = 23 * MiB, WS_UVGS = 24 * MiB, WS_KVQGS = 27 * MiB,
                 WS_XN = 29 * MiB  , WS_VT = 62 * MiB  , WS_Y = 126 * MiB  , WS_END = 191 * MiB;
constexpr size_t OUT_YS = (size_t)TP * DM, OUT_KP = OUT_YS + (size_t)TS * DM, OUT_VP = OUT_KP + 262144, OUT_KS = OUT_VP + 262144, OUT_VS = OUT_KS + 4194304, OUT_AV = OUT_VS + 4194304;

__device__ __forceinline__ unsigned pk2(float a, float b) { return pg8::cvt_pk_bf16(a, b); }
__device__ __forceinline__ float bf2f(unsigned short h) { return __uint_as_float(((unsigned)h) << 16); }
__device__ __forceinline__ float silu(float x) { return x / (1.0f + __expf(-x)); }
__device__ __forceinline__ float wave_sum(float v) {
#pragma unroll
    for (int o = 1; o < 64; o <<= 1) v += __shfl_xor(v, o);
    return v;
}
__device__ __forceinline__ float wave_max(float v) {
#pragma unroll
    for (int o = 1; o < 64; o <<= 1) v = fmaxf(v, __shfl_xor(v, o));
    return v;
}
__device__ __forceinline__ u32x4 pack8(const f32x4 a, const f32x4 b) { u32x4 w; w.x = pk2(a[0], a[1]); w.y = pk2(a[2], a[3]); w.z = pk2(b[0], b[1]); w.w = pk2(b[2], b[3]); return w; }
#define LDS_WAIT() asm volatile("s_waitcnt lgkmcnt(0)" ::: "memory")

struct Params {
    const float *x_prompt, *x_sample, *cache_k, *cache_v, *norm_a, *w_in_a, *v_norm_a, *w_s_a, *b_s_a, *w_out_a, *kv_norm, *w_kv, *norm_b, *w_in_b, *sinks_b, *w_out_b, *final_norm;
    float* out; unsigned char* ws;
};
typedef const __attribute__((address_space(4))) Params* ArgP;

struct EpiVT {
    static constexpr bool PERM = true, AFTER_DRAIN = false;
    bf16_t* VT; float* vsq;
    __device__ __forceinline__ void operator()(const f32x4 (&acc)[2][2][4][2], const Unit& u, int wr_, int wc_, int fr_, int fq_) const {
        int fr = fr_, fq = fq_, wr = wr_, wc = wc_; asm volatile("" : "+v"(fr), "+v"(fq), "+s"(wr), "+s"(wc));
        const int t0 = u.pn * 256 + wc * 32 + 8 * fq;
        float cs[2][8];
#pragma unroll
        for (int bj = 0; bj < 2; ++bj)
#pragma unroll
            for (int j = 0; j < 8; ++j) cs[bj][j] = 0.f;
#pragma unroll
        for (int ai = 0; ai < 2; ++ai)
#pragma unroll
            for (int m = 0; m < 4; ++m) {
                const int c = u.pm * 256 + ai * 128 + wr * 64 + m * 16 + fr;
#pragma unroll
                for (int bj = 0; bj < 2; ++bj) {
                    const f32x4 v0 = acc[ai][bj][m][0], v1 = acc[ai][bj][m][1];
                    *(u32x4*)(VT + (size_t)c * TP + t0 + 128 * bj) = pack8(v0, v1);
#pragma unroll
                    for (int e = 0; e < 4; ++e) { cs[bj][e] += v0[e] * v0[e]; cs[bj][4 + e] += v1[e] * v1[e]; }
                }
            }
#pragma unroll
        for (int bj = 0; bj < 2; ++bj)
#pragma unroll
            for (int j = 0; j < 8; ++j) {
                float s = cs[bj][j];
                s += __shfl_xor(s, 1); s += __shfl_xor(s, 2); s += __shfl_xor(s, 4); s += __shfl_xor(s, 8);
                if (fr == 0) unsafeAtomicAdd(vsq + t0 + 128 * bj + j, s);
            }
    }
};

constexpr int WSL_BYTES = 20480;
struct EpiUG {
    static constexpr bool PERM = true, AFTER_DRAIN = false;
    const bf16_t* VT; const float* vsq; const float* w_s; const float* b_s; const float* gv; bf16_t* Y; LAS unsigned char* wl;
    __device__ __forceinline__ void operator()(const f32x4 (&acc)[2][2][4][2], const Unit& u, int wr_, int wc_, int fr_, int fq_) const {
        int fr = fr_, fq = fq_, wr = wr_, wc = wc_; asm volatile("" : "+v"(fr), "+v"(fq), "+s"(wr), "+s"(wc));
        const int g = u.pn >> 1, cb = 128 * u.pn + 32 * wc;
        const int chA0 = cb + 8 * (fr >> 2) + (fr & 3);
        const int chL = cb + 8 * fq;
        const int tid = wr * 256 + wc * 64 + fq * 16 + fr;
        const f32x4 gv0 = *(const f32x4*)(gv + chL), gv1 = *(const f32x4*)(gv + chL + 4);
#pragma unroll
        for (int ai = 0; ai < 2; ++ai) {
            const int tok0 = (2 * u.pm + ai) * 128;
            bf16x8 va[2][4]; float bias[4];
#pragma unroll
            for (int n = 0; n < 2; ++n)
#pragma unroll
                for (int kk = 0; kk < 4; ++kk) va[n][kk] = *(const bf16x8*)(VT + (size_t)(chA0 + 4 * n) * TP + tok0 + 32 * kk + 8 * fq);
#pragma unroll
            for (int m = 0; m < 4; ++m) bias[m] = b_s[g * 128 + 64 * wr + 16 * m + fr];
            asm volatile("s_waitcnt lgkmcnt(0)" ::: "memory"); __builtin_amdgcn_s_barrier(); asm volatile("" ::: "memory");
#pragma unroll
            for (int it = 0; it < 3; ++it) {
                const int c = tid + 512 * it;
                if (c < 1280) {
                    int rb, cc; if (c < 128) { rb = 0; cc = c; } else if (c < 384) { rb = 1; cc = c - 128; } else if (c < 768) { rb = 2; cc = c - 384; } else { rb = 3; cc = c - 768; }
                    int row, ch; if (rb == 0) { row = cc >> 2; ch = cc & 3; } else if (rb == 1) { row = cc >> 3; ch = cc & 7; } else if (rb == 2) { row = cc / 12; ch = cc - 12 * row; } else { row = cc >> 4; ch = cc & 15; }
                    const int i = 32 * rb + row, j0 = 8 * ch;
                    const float* wp = w_s + ((size_t)g * 128 + i) * 128 + j0; const float* qp = vsq + tok0 + j0;
                    const f32x4 w0 = *(const f32x4*)wp, w1 = *(const f32x4*)(wp + 4), q0 = *(const f32x4*)qp, q1 = *(const f32x4*)(qp + 4);
                    f32x4 t0, t1;
#pragma unroll
                    for (int e2 = 0; e2 < 4; ++e2) {
                        t0[e2] = (j0 + e2 <= i) ? w0[e2] * rsqrtf(q0[e2] * (1.0f / AW) + EPS) : 0.f;
                        t1[e2] = (j0 + 4 + e2 <= i) ? w1[e2] * rsqrtf(q1[e2] * (1.0f / AW) + EPS) : 0.f; }
                    const int wbase = 1024 * rb * (rb + 1);
                    *(LAS u32x4*)(wl + wbase + row * 64 * (rb + 1) + ch * 16) = pack8(t0, t1);
                }
            }
            asm volatile("s_waitcnt lgkmcnt(0)" ::: "memory"); __builtin_amdgcn_s_barrier(); asm volatile("" ::: "memory");
#pragma unroll
            for (int m = 0; m < 4; ++m) {
                const int i = 64 * wr + 16 * m + fr, rb = 2 * wr + (m >> 1);
                const LAS unsigned char* wrow = wl + 1024 * rb * (rb + 1) + (i & 31) * 64 * (rb + 1) + fq * 16;
                f32x4 z0 = {0.f, 0.f, 0.f, 0.f}, z1 = {0.f, 0.f, 0.f, 0.f};
#pragma unroll
                for (int kk = 0; kk < 4; ++kk) {
                    if (kk <= rb) {
                        const bf16x8 bfv = *(const LAS bf16x8*)(wrow + kk * 64);
                        z0 = __builtin_amdgcn_mfma_f32_16x16x32_bf16(va[0][kk], bfv, z0, 0, 0, 0);
                        z1 = __builtin_amdgcn_mfma_f32_16x16x32_bf16(va[1][kk], bfv, z1, 0, 0, 0);
                    }
                }
                const f32x4 u0 = acc[ai][0][m][0], u1 = acc[ai][0][m][1], g0 = acc[ai][1][m][0], g1 = acc[ai][1][m][1];
                f32x4 y0, y1;
#pragma unroll
                for (int e = 0; e < 4; ++e) { y0[e] = u0[e] * (gv0[e] * z0[e] + bias[m]) * silu(g0[e]); y1[e] = u1[e] * (gv1[e] * z1[e] + bias[m]) * silu(g1[e]); }
                *(u32x4*)(Y + (size_t)(tok0 + i) * AW + chL) = pack8(y0, y1);
            }
        }
    }
};

template <bool WITH_BF16> struct EpiRes {
    static constexpr bool PERM = true, AFTER_DRAIN = false;
    const float* base; float* H; bf16_t* Hb; float* sq;
    __device__ __forceinline__ void operator()(const f32x4 (&acc)[2][2][4][2], const Unit& u, int wr_, int wc_, int fr_, int fq_) const {
        int fr = fr_, fq = fq_, wr = wr_, wc = wc_; asm volatile("" : "+v"(fr), "+v"(fq), "+s"(wr), "+s"(wc));
        const int col0 = u.pn * 256 + wc * 32 + 8 * fq;
#pragma unroll
        for (int ai = 0; ai < 2; ++ai)
#pragma unroll
            for (int m = 0; m < 4; ++m) {
                const int row = u.pm * 256 + ai * 128 + wr * 64 + m * 16 + fr; float s = 0.f;
#pragma unroll
                for (int bj = 0; bj < 2; ++bj) {
                    const size_t off = (size_t)row * DM + col0 + 128 * bj;
                    const f32x4 h0 = acc[ai][bj][m][0] + *(const f32x4*)(base + off), h1 = acc[ai][bj][m][1] + *(const f32x4*)(base + off + 4);
                    *(f32x4*)(H + off) = h0; *(f32x4*)(H + off + 4) = h1;
                    if (WITH_BF16) *(u32x4*)(Hb + off) = pack8(h0, h1);
#pragma unroll
                    for (int e = 0; e < 4; ++e) s += h0[e] * h0[e] + h1[e] * h1[e];
                }
                s += __shfl_xor(s, 16); s += __shfl_xor(s, 32);
                if (fq == 0) unsafeAtomicAdd(sq + row, s);
                if (m & 1) asm volatile("" ::: "memory");
            }
    }
};

struct Epi3 {
    static constexpr bool PERM = true, AFTER_DRAIN = false;
    const float* hsq; const float* rope; bf16_t *Kb, *Vb, *Qb, *Gb; float *outk, *outv;
    __device__ __forceinline__ void operator()(const f32x4 (&acc)[2][2][4][2], const Unit& u, int wr_, int wc_, int fr_, int fq_) const {
        int fr = fr_, fq = fq_, wr = wr_, wc = wc_; asm volatile("" : "+v"(fr), "+v"(fq), "+s"(wr), "+s"(wc));
        const int pn = u.pn; const bool rot = (pn == 0 || (pn >= 2 && pn < 6)) && ((wc & 1) == 0);
#pragma unroll
        for (int ai = 0; ai < 2; ++ai)
#pragma unroll
            for (int m = 0; m < 4; ++m) {
                const int row = u.pm * 256 + ai * 128 + wr * 64 + m * 16 + fr, pos = row & 2047, b = row >> 11;
                const float rs = rsqrtf(hsq[row] * (1.0f / DM) + EPS);
                const float* rp = rope + pos * 16;
#pragma unroll
                for (int bj = 0; bj < 2; ++bj) {
                    f32x4 v0 = acc[ai][bj][m][0] * rs, v1 = acc[ai][bj][m][1] * rs;
                    const int cw = 128 * bj + 32 * wc + 8 * fq;
                    if (rot) {
                        const f32x4 c0 = *(const f32x4*)(rp), c1 = *(const f32x4*)(rp + 4), s0 = *(const f32x4*)(rp + 8), s1 = *(const f32x4*)(rp + 12);
#pragma unroll
                        for (int e = 0; e < 4; ++e) {
                            const float p0 = __shfl_xor(v0[e], 16), p1 = __shfl_xor(v1[e], 16);
                            const float a0 = fq == 0 ? v0[e] * c0[e] - p0 * s0[e] : v0[e] * c0[e] + p0 * s0[e];
                            const float a1 = fq == 0 ? v1[e] * c1[e] - p1 * s1[e] : v1[e] * c1[e] + p1 * s1[e];
                            if (fq < 2) { v0[e] = a0; v1[e] = a1; }
                        }
                    }
                    if (pn == 0) {
                        *(u32x4*)(Kb + (size_t)row * 256 + cw) = pack8(v0, v1);
                        if (pos >= 1920) { float* o = outk + ((size_t)(b * 128 + pos - 1920)) * 256 + cw; *(f32x4*)o = v0; *(f32x4*)(o + 4) = v1; }
                    } else if (pn == 1) {
                        *(u32x4*)(Vb + (size_t)row * 256 + cw) = pack8(v0, v1);
                        if (pos >= 1920) { float* o = outv + ((size_t)(b * 128 + pos - 1920)) * 256 + cw; *(f32x4*)o = v0; *(f32x4*)(o + 4) = v1; }
                    } else if (pn < 6) {
                        *(u32x4*)(Qb + (size_t)row * DM + 256 * (pn - 2) + cw) = pack8(v0 * 0.125f, v1 * 0.125f);
                    } else {
                        f32x4 g0, g1;
#pragma unroll
                        for (int e = 0; e < 4; ++e) { g0[e] = silu(v0[e]); g1[e] = silu(v1[e]); }
                        *(u32x4*)(Gb + (size_t)row * DM + 256 * (pn - 6) + cw) = pack8(g0, g1);
                    }
                }
                asm volatile("" ::: "memory");
            }
    }
};


struct EpiNull {
    static constexpr bool PERM = true, AFTER_DRAIN = false;
    float* dummy;
    __device__ __forceinline__ void operator()(const f32x4 (&acc)[2][2][4][2], const Unit& u, int wr, int wc, int fr, int fq) const {
        float s = 0.f;
#pragma unroll
        for (int ai = 0; ai < 2; ++ai)
#pragma unroll
            for (int bj = 0; bj < 2; ++bj)
#pragma unroll
                for (int m = 0; m < 4; ++m)
#pragma unroll
                    for (int n = 0; n < 2; ++n) s += (acc[ai][bj][m][n][0] + acc[ai][bj][m][n][1]) + (acc[ai][bj][m][n][2] + acc[ai][bj][m][n][3]);
        if (s == 123456.789f) dummy[u.pm * 64 + u.pn + wr + wc + fr + fq] = s;
    }
};
template <class F> __device__ __forceinline__ void mini_gemm(const bf16_t* A, const bf16_t* Bt, int K, int N, int gw, int NGW, int lane, F epi) {
    const int fr = lane & 15, fq = lane >> 4, ntask = 8 * (N / 32);
    for (int task = gw; task < ntask; task += NGW) {
        const int rt = task & 7, ct = task >> 3;
        const bf16x8* ap = (const bf16x8*)(A + (size_t)(rt * 16 + fr) * K + 8 * fq);
        const bf16x8* b0 = (const bf16x8*)(Bt + (size_t)(ct * 32 + fr) * K + 8 * fq);
        const bf16x8* b1 = (const bf16x8*)(Bt + (size_t)(ct * 32 + 16 + fr) * K + 8 * fq);
        f32x4 c0 = {0.f, 0.f, 0.f, 0.f}, c1 = {0.f, 0.f, 0.f, 0.f};
        for (int kb = 0; kb < K / 32; kb += 8) {
            bf16x8 a[8], x0[8], x1[8];
#pragma unroll
            for (int i = 0; i < 8; ++i) { a[i] = ap[(kb + i) * 4]; x0[i] = b0[(kb + i) * 4]; x1[i] = b1[(kb + i) * 4]; }
            __builtin_amdgcn_sched_barrier(0);
#pragma unroll
            for (int i = 0; i < 8; ++i) {
                c0 = __builtin_amdgcn_mfma_f32_16x16x32_bf16(x0[i], a[i], c0, 0, 0, 0);
                c1 = __builtin_amdgcn_mfma_f32_16x16x32_bf16(x1[i], a[i], c1, 0, 0, 0);
            }
            __builtin_amdgcn_sched_barrier(0);
        }
        epi(rt * 16 + fr, ct * 32 + 4 * fq, c0); epi(rt * 16 + fr, ct * 32 + 16 + 4 * fq, c1);
    }
}

__device__ __forceinline__ void transpose_item(const float* W, int N, int K, const float* gain, bf16_t* dst, LAS float* scr, int k0, int n0, int lane) {
#pragma unroll 8
    for (int i = 0; i < 32; ++i) { const int kk = 2 * i + (lane >> 5); const float gk = gain ? gain[k0 + kk] : 1.0f; scr[kk * 33 + (lane & 31)] = W[(size_t)(k0 + kk) * N + n0 + (lane & 31)] * gk; }
    LDS_WAIT();
    const int c = lane & 7;
#pragma unroll
    for (int j = 0; j < 4; ++j) { const int n = (lane >> 3) + 8 * j; const LAS float* s = scr + (8 * c) * 33 + n;
        u32x4 o; o.x = pk2(s[0 * 33], s[1 * 33]); o.y = pk2(s[2 * 33], s[3 * 33]); o.z = pk2(s[4 * 33], s[5 * 33]); o.w = pk2(s[6 * 33], s[7 * 33]);
        *(u32x4*)(dst + (size_t)n * K + k0 + 8 * c) = o; }
    LDS_WAIT();
}
__device__ __forceinline__ float rope_inv(int i) {
    return i == 0 ? 1.0f : i == 1 ? 0.19392274474868576f : i == 2 ? 0.03760603093086393f : i == 3 ? 0.007292664737217109f : i == 4 ? 0.001414213562373095f :
           i == 5 ? 0.0002742481756762073f : i == 6 ? 5.318295896944988e-05f : 1.031338537721246e-05f;
}

__device__ __forceinline__ void prologue(ArgP P, LAS unsigned char* lds, int gw, int NGW, int wave, int lane) {
    unsigned char* ws = P->ws;
    LAS float* scr = (LAS float*)(lds + wave * 8704);
    bf16_t* W1t = (bf16_t*)(ws + WS_W1); bf16_t* W2t = (bf16_t*)(ws + WS_W2); bf16_t* W3t = (bf16_t*)(ws + WS_W3); bf16_t* W4t = (bf16_t*)(ws + WS_W4);
    constexpr int I1 = 16 * 192, I2 = 32 * 32, I3 = 16 * 16, I4 = 16 * 64, I5 = 16 * 32;
    for (int it = gw; it < I1 + I2 + I3 + I4 + I5; it += NGW) {
        int r = it;
        if (r < I1) { const int kb = r / 192, nb = r % 192, n0 = 32 * nb, ty = n0 >> 11, ch = n0 & 2047;
            const int drow = ty == 1 ? ch : 2048 + (ch >> 7) * 256 + (ch & 127) + (ty == 2 ? 128 : 0);
            transpose_item(P->w_in_a, 6144, 1024, P->norm_a, W1t + (size_t)drow * 1024, scr, 64 * kb, n0, lane); continue; }
        r -= I1;
        if (r < I2) { const int kb = r / 32, nb = r % 32; transpose_item(P->w_out_a, 1024, 2048, nullptr, W2t + (size_t)(32 * nb) * 2048, scr, 64 * kb, 32 * nb, lane); continue; }
        r -= I2;
        if (r < I3) { const int kb = r / 16, nb = r % 16; transpose_item(P->w_kv, 512, 1024, P->kv_norm, W3t + (size_t)(32 * nb) * 1024, scr, 64 * kb, 32 * nb, lane); continue; }
        r -= I3;
        if (r < I4) { const int kb = r / 64, nb = r % 64; transpose_item(P->w_in_b, 2048, 1024, P->norm_b, W3t + (size_t)(512 + 32 * nb) * 1024, scr, 64 * kb, 32 * nb, lane); continue; }
        r -= I4;
        { const int kb = r / 32, nb = r % 32; transpose_item(P->w_out_b, 1024, 1024, nullptr, W4t + (size_t)(32 * nb) * 1024, scr, 64 * kb, 32 * nb, lane); }
    }
    bf16_t* XN = (bf16_t*)(ws + WS_XN);
    for (int row = gw; row < TT; row += NGW) {
        const float* xr = row < TP ? P->x_prompt + (size_t)row * DM : P->x_sample + (size_t)(row - TP) * DM;
        f32x4 v[4]; float s = 0.f;
#pragma unroll
        for (int j = 0; j < 4; ++j) { v[j] = *(const f32x4*)(xr + 4 * lane + 256 * j); s += (v[j][0] * v[j][0] + v[j][1] * v[j][1]) + (v[j][2] * v[j][2] + v[j][3] * v[j][3]); }
        const float rs = rsqrtf(wave_sum(s) * (1.0f / DM) + EPS);
#pragma unroll
        for (int j = 0; j < 4; ++j) { u32x2 o; o.x = pk2(v[j][0] * rs, v[j][1] * rs); o.y = pk2(v[j][2] * rs, v[j][3] * rs); *(u32x2*)(XN + (size_t)row * DM + 4 * lane + 256 * j) = o; }
    }
    const int gt = gw * 64 + lane, NGT = NGW * 64;
    float* small = (float*)(ws + WS_SMALL);
    for (int i = gt; i < 3 * 32768; i += NGT) small[i] = 0.f;
    float* rope = small + 3 * 32768;
    for (int i = gt; i < 2049 * 8; i += NGT) {
        const int idx = i >> 3, k = i & 7; const float pos = idx < 2048 ? (float)idx : 8192.0f;
        const float ang = pos * rope_inv(k);
        double rev = (double)ang * 0.15915494309189535; rev -= floor(rev);
        const float rf = (float)rev;
        rope[idx * 16 + k] = __builtin_amdgcn_cosf(rf); rope[idx * 16 + 8 + k] = __builtin_amdgcn_sinf(rf);
    }
    for (int i = gt; i < 2 * 128 * 127 * 64; i += NGT) {
        const int which = i >= 128 * 127 * 64; const int r = which ? i - 128 * 127 * 64 : i;
        const int b = r / (127 * 64), rem = r % (127 * 64), j = rem >> 6, q = rem & 63;
        const float* src = (which ? P->cache_v : P->cache_k) + ((size_t)(b * 128 + j + 1)) * 256 + 4 * q;
        float* dst = P->out + (which ? OUT_VS : OUT_KS) + ((size_t)(b * 128 + j)) * 256 + 4 * q;
        *(f32x4*)dst = *(const f32x4*)src;
    }
}

__device__ __forceinline__ void attn_prompt(LAS unsigned char* lds, const bf16_t* Qb, const bf16_t* Kb, const bf16_t* Vb, const bf16_t* Gb, const float* sinks, bf16_t* OG, int G, int bid, int tid, int wave, int lane) {
    LAS bf16_t* Kl = (LAS bf16_t*)lds;
    LAS bf16_t* Vl = Kl + 256 * 72;
    const int fr = lane & 15, fq = lane >> 4;
    for (int unit = bid; unit < 512; unit += G) {
        const int kvh = unit & 3, nb = (unit >> 2) & 15, b = unit >> 6;
        __syncthreads();
#pragma unroll
        for (int i = 0; i < 4; ++i) {
            const int c = tid + 512 * i, row = c >> 3, ch = c & 7, pos = 128 * nb - 128 + row;
            u32x4 kx = {0u, 0u, 0u, 0u}, vx = {0u, 0u, 0u, 0u};
            if (pos >= 0) { const size_t off = ((size_t)(b * 2048 + pos)) * 256 + kvh * 64 + ch * 8; kx = *(const u32x4*)(Kb + off); vx = *(const u32x4*)(Vb + off); }
            *(LAS u32x4*)(Kl + row * 72 + ch * 8) = kx;
            LAS bf16_t* vd = Vl + (ch * 8) * 264 + row;
            vd[0 * 264] = (bf16_t)(vx.x & 0xffffu); vd[1 * 264] = (bf16_t)(vx.x >> 16); vd[2 * 264] = (bf16_t)(vx.y & 0xffffu); vd[3 * 264] = (bf16_t)(vx.y >> 16);
            vd[4 * 264] = (bf16_t)(vx.z & 0xffffu); vd[5 * 264] = (bf16_t)(vx.z >> 16); vd[6 * 264] = (bf16_t)(vx.w & 0xffffu); vd[7 * 264] = (bf16_t)(vx.w >> 16);
        }
        __syncthreads();
        const int qt = wave;
        const size_t qrow = (size_t)(b * 2048 + 128 * nb + 16 * qt + fr);
        for (int hq = 0; hq < 4; ++hq) {
            const int head = 4 * kvh + hq;
            const bf16x8 q0 = *(const bf16x8*)(Qb + qrow * DM + head * 64 + 8 * fq), q1 = *(const bf16x8*)(Qb + qrow * DM + head * 64 + 32 + 8 * fq);
            f32x4 S[9];
#pragma unroll
            for (int t = 0; t < 9; ++t) {
                const LAS bf16_t* kp = Kl + (16 * (qt + t) + fr) * 72 + 8 * fq;
                const bf16x8 a0 = *(const LAS bf16x8*)kp, a1 = *(const LAS bf16x8*)(kp + 32);
                f32x4 s = {0.f, 0.f, 0.f, 0.f};
                s = __builtin_amdgcn_mfma_f32_16x16x32_bf16(a0, q0, s, 0, 0, 0);
                s = __builtin_amdgcn_mfma_f32_16x16x32_bf16(a1, q1, s, 0, 0, 0);
                S[t] = s;
            }
            const float sink = sinks[head];
            float mx = sink;
#pragma unroll
            for (int t = 0; t < 9; ++t)
#pragma unroll
                for (int e = 0; e < 4; ++e) {
                    const int dl = 16 * t + 4 * fq + e - fr, j = 16 * (qt + t) + 4 * fq + e;
                    const bool ok = dl >= 0 && dl <= 128 && (nb > 0 || j >= 128);
                    S[t][e] = ok ? S[t][e] : -INFINITY;
                    mx = fmaxf(mx, S[t][e]);
                }
            mx = fmaxf(mx, __shfl_xor(mx, 16)); mx = fmaxf(mx, __shfl_xor(mx, 32));
            float sum = 0.f;
#pragma unroll
            for (int t = 0; t < 9; ++t)
#pragma unroll
                for (int e = 0; e < 4; ++e) { const float p = __expf(S[t][e] - mx); S[t][e] = p; sum += p; }
            sum += __shfl_xor(sum, 16); sum += __shfl_xor(sum, 32);
            const float inv = 1.0f / (sum + __expf(sink - mx));
            f32x4 O[4];
#pragma unroll
            for (int dt = 0; dt < 4; ++dt) O[dt] = (f32x4){0.f, 0.f, 0.f, 0.f};
#pragma unroll
            for (int tp = 0; tp < 5; ++tp) {
                const int ta = 2 * tp, tb = 2 * tp + 1 < 9 ? 2 * tp + 1 : 8;
                const f32x4 pa = S[ta], pb = (2 * tp + 1 < 9) ? S[tb] : (f32x4){0.f, 0.f, 0.f, 0.f};
                const bf16x8 bfv = __builtin_bit_cast(bf16x8, pack8(pa, pb));
#pragma unroll
                for (int dt = 0; dt < 4; ++dt) {
                    const LAS bf16_t* vp = Vl + (16 * dt + fr) * 264 + 4 * fq;
                    u32x4 av; const u32x2 lo = *(const LAS u32x2*)(vp + 16 * (qt + ta)), hi = *(const LAS u32x2*)(vp + 16 * (qt + tb));
                    av.x = lo.x; av.y = lo.y; av.z = hi.x; av.w = hi.y;
                    O[dt] = __builtin_amdgcn_mfma_f32_16x16x32_bf16(__builtin_bit_cast(bf16x8, av), bfv, O[dt], 0, 0, 0);
                }
            }
#pragma unroll
            for (int dt = 0; dt < 4; ++dt) {
                const size_t off = qrow * DM + head * 64 + 16 * dt + 4 * fq;
                const u32x2 gg = *(const u32x2*)(Gb + off);
                u32x2 o;
                o.x = pk2(O[dt][0] * inv * __uint_as_float(gg.x << 16), O[dt][1] * inv * __uint_as_float(gg.x & 0xffff0000u));
                o.y = pk2(O[dt][2] * inv * __uint_as_float(gg.y << 16), O[dt][3] * inv * __uint_as_float(gg.y & 0xffff0000u));
                *(u32x2*)(OG + off) = o;
            }
        }
    }
}

__device__ __forceinline__ void attn_sample(const float* cache_k, const float* cache_v, const float* sinks_b, float* out, const float* KVQGS, const float* rope, bf16_t* OG, int gw, int NGW, int lane) {
    for (int task = gw; task < 512; task += NGW) {
        const int b = task >> 2, kvh = task & 3;
        const float* rowp = KVQGS + (size_t)b * 2560;
        const float* rp = rope + 2048 * 16;
        const float cs = rp[lane & 7], sn = rp[8 + (lane & 7)];
        float q[4];
#pragma unroll
        for (int hq = 0; hq < 4; ++hq) {
            float x = rowp[512 + (4 * kvh + hq) * 64 + lane]; const float pr = __shfl_xor(x, 8);
            if (lane < 8) x = x * cs - pr * sn; else if (lane < 16) x = x * cs + pr * sn;
            q[hq] = x * 0.125f;
        }
        float kn = rowp[kvh * 64 + lane]; { const float pr = __shfl_xor(kn, 8); if (lane < 8) kn = kn * cs - pr * sn; else if (lane < 16) kn = kn * cs + pr * sn; }
        const float vn = rowp[256 + kvh * 64 + lane];
        out[OUT_KS + ((size_t)(b * 128 + 127)) * 256 + kvh * 64 + lane] = kn;
        out[OUT_VS + ((size_t)(b * 128 + 127)) * 256 + kvh * 64 + lane] = vn;
        const float* k0p = cache_k + ((size_t)(b * 128 + lane)) * 256 + kvh * 64;
        const float* k1p = k0p + 64 * 256;
        float s0[4] = {0.f, 0.f, 0.f, 0.f}, s1[4] = {0.f, 0.f, 0.f, 0.f};
#pragma unroll
        for (int d4 = 0; d4 < 16; ++d4) {
            const f32x4 ka = *(const f32x4*)(k0p + 4 * d4), kb = *(const f32x4*)(k1p + 4 * d4);
#pragma unroll
            for (int c = 0; c < 4; ++c)
#pragma unroll
                for (int hq = 0; hq < 4; ++hq) { const float qd = __int_as_float(__builtin_amdgcn_readlane(__float_as_int(q[hq]), 4 * d4 + c)); s0[hq] += qd * ka[c]; s1[hq] += qd * kb[c]; }
        }
        float o[4];
#pragma unroll
        for (int hq = 0; hq < 4; ++hq) {
            const float snew = wave_sum(q[hq] * kn), sink = sinks_b[4 * kvh + hq];
            const float mx = fmaxf(fmaxf(wave_max(fmaxf(s0[hq], s1[hq])), snew), sink);
            const float p0 = __expf(s0[hq] - mx), p1 = __expf(s1[hq] - mx), pn = __expf(snew - mx);
            const float den = wave_sum(p0 + p1) + pn + __expf(sink - mx);
            s0[hq] = p0 / den; s1[hq] = p1 / den; o[hq] = (pn / den) * vn;
        }
        const float* vp = cache_v + ((size_t)(b * 128)) * 256 + kvh * 64 + lane;
#pragma unroll 8
        for (int key = 0; key < 64; ++key) {
            const float va = vp[(size_t)key * 256], vb = vp[(size_t)(key + 64) * 256];
#pragma unroll
            for (int hq = 0; hq < 4; ++hq) {
                o[hq] += __int_as_float(__builtin_amdgcn_readlane(__float_as_int(s0[hq]), key)) * va;
                o[hq] += __int_as_float(__builtin_amdgcn_readlane(__float_as_int(s1[hq]), key)) * vb;
            }
        }
#pragma unroll
        for (int hq = 0; hq < 4; ++hq) {
            const int col = (4 * kvh + hq) * 64 + lane;
            const float gt = silu(rowp[1536 + col]);
            const unsigned w = pk2(o[hq] * gt, 0.f);
            OG[(size_t)(TP + b) * DM + col] = (bf16_t)(w & 0xffffu);
        }
    }
}


#ifndef REP0
#define REP0 1
#endif
#ifndef REP1
#define REP1 1
#endif
#ifndef REP2
#define REP2 1
#endif
#ifndef REP3
#define REP3 1
#endif
#ifndef REP4
#define REP4 1
#endif
#ifndef REP5
#define REP5 1
#endif
#ifndef REP6
#define REP6 1
#endif
#ifndef REP7
#define REP7 1
#endif
#ifndef REPS
#define REPS 1
#endif
#define GSYNC() do { for (int r_ = 0; r_ < REPS; ++r_) { ArgP A_ = args_ptr(); xcd_barrier((unsigned*)(A_->ws + WS_SMALL) + BAR_F32_IDX, bst); } } while (0)
constexpr size_t WS_DUMMY = WS_END;

#define XB_TMO      128
#define XB_XCNT(j)  (256  + 64 * (j))
#define XB_XSUB(j)  (1280 + 64 * (j))
#define XB_XGEN(j)  (2304 + 64 * (j))
#define XB_TOP      3328
#define XB_TOPGEN   3392
#define XCD_BAR_WORDS 3456
#define XB_SPIN_CAP (1u << 18)
__device__ __forceinline__ unsigned xb_ld(unsigned* p)              { return __hip_atomic_load(p, __ATOMIC_RELAXED, __HIP_MEMORY_SCOPE_AGENT); }
__device__ __forceinline__ unsigned xb_add(unsigned* p, unsigned v) { return __hip_atomic_fetch_add(p, v, __ATOMIC_RELAXED, __HIP_MEMORY_SCOPE_AGENT); }
__device__ __forceinline__ unsigned xb_xcc_id() { return (unsigned)__builtin_amdgcn_s_getreg((3 << 11) | 20) & 0xFu; }
#define XB_SPIN(cond, bar) do { unsigned _sp = 0; while (cond) { __builtin_amdgcn_s_sleep(1); \
    if ((++_sp & 255u) == 0u) { if (xb_ld(&(bar)[XB_TMO])) break; if (_sp > XB_SPIN_CAP) { atomicAdd(&(bar)[XB_TMO], 1u); break; } } } } while (0)
__device__ __forceinline__ void xcd_barrier_complete(unsigned* bar, unsigned x, unsigned& nloc, unsigned& nx) {
    const unsigned G = gridDim.x * gridDim.y * gridDim.z;
    unsigned sum, cnt, mine, sp = 0u;
    for (;;) {
        sum = 0u; cnt = 0u; mine = 0u;
#pragma unroll
        for (unsigned j = 0; j < 16; ++j) { const unsigned c = xb_ld(&bar[XB_XCNT(j)]); sum += c; cnt += (c > 0u) ? 1u : 0u; mine = (j == x) ? c : mine; }
        if (sum == G) break;
        __builtin_amdgcn_s_sleep(1);
        if ((++sp & 255u) == 0u) { if (xb_ld(&bar[XB_TMO])) break; if (sp > XB_SPIN_CAP) { atomicAdd(&bar[XB_TMO], 1u); break; } }
    }
    nloc = mine > 0u ? mine : 1u; nx = cnt > 0u ? cnt : 1u;
}
__device__ __forceinline__ void xcd_barrier(unsigned* bar, volatile LAS unsigned* st) {
    asm volatile("s_waitcnt vmcnt(0)" ::: "memory");
    __syncthreads();
    if (threadIdx.x == 0) {
        const unsigned x = xb_xcc_id();
        __builtin_amdgcn_s_waitcnt(0);
        unsigned nloc = st[0], nx = st[1];
        if (nloc == 0u) { xcd_barrier_complete(bar, x, nloc, nx); st[0] = nloc; st[1] = nx; }
        const unsigned old = xb_add(&bar[XB_XSUB(x)], 1u);
        const unsigned gen = old / nloc;
        if (old + 1u == (gen + 1u) * nloc) {
            __builtin_amdgcn_fence(__ATOMIC_RELEASE, "agent");
            asm volatile("s_waitcnt vmcnt(0)" ::: "memory");
            const unsigned og = xb_add(&bar[XB_TOP], 1u);
            const unsigned tg = og / nx;
            if (og + 1u == (tg + 1u) * nx) xb_add(&bar[XB_TOPGEN], 1u);
            else XB_SPIN(xb_ld(&bar[XB_TOPGEN]) == tg, bar);
            __builtin_amdgcn_fence(__ATOMIC_ACQUIRE, "agent");
            xb_add(&bar[XB_XGEN(x)], 1u);
            asm volatile("s_waitcnt vmcnt(0)" ::: "memory");
        } else {
            XB_SPIN(xb_ld(&bar[XB_XGEN(x)]) == gen, bar);
            __builtin_amdgcn_fence(__ATOMIC_ACQUIRE, "agent");
            asm volatile("s_waitcnt vmcnt(0)" ::: "memory");
        }
    }
    __syncthreads();
}
constexpr int BAR_F32_IDX = 200704;
__device__ __forceinline__ ArgP args_ptr() { ArgP p = (ArgP)__builtin_amdgcn_kernarg_segment_ptr(); asm volatile("" : "+s"(p)); return p; }
#define WSP(T, off) ((T*)(ws + (off)))
#define SMALLF(i) (WSP(float, WS_SMALL) + (i) * 32768)

__global__ void __launch_bounds__(512, 2) yoco_fwd(Params Pin) {
    extern __shared__ __attribute__((aligned(16))) unsigned char lds_raw[];
    LAS unsigned char* lds = (LAS unsigned char*)lds_raw;
    cg::grid_group grid = cg::this_grid();
    const int tid0 = threadIdx.x, wave = __builtin_amdgcn_readfirstlane(tid0 >> 6);
#define PH_IDS int tid = tid0; asm volatile("" : "+v"(tid)); const int lane = tid & 63; (void)lane
    const int G = gridDim.x, bid = blockIdx.x, gw = bid * NWV + wave, NGW = G * NWV;
    volatile LAS unsigned* bst = (volatile LAS unsigned*)(lds + pg8::STAGE_BYTES);
    { ArgP A_ = args_ptr(); unsigned char* ws_ = A_->ws; unsigned* bar = (unsigned*)(ws_ + WS_SMALL) + BAR_F32_IDX;
      if (ws_ == nullptr) grid.sync();
      if (tid0 == 0) { bst[0] = 0u; bst[1] = 0u; (void)xb_add(&bar[XB_XCNT(xb_xcc_id())], 1u); } }
    __syncthreads();

    for (int rep = 0; rep < REP0; ++rep) { PH_IDS; ArgP A = args_ptr(); prologue(A, lds, gw, NGW, wave, lane); }
    GSYNC();

    for (int rep = 0; rep < REP1; ++rep) {
        PH_IDS; ArgP A = args_ptr(); unsigned char* ws = A->ws;
        pg8::Gemm g{WSP(bf16_t, WS_W1), WSP(bf16_t, WS_XN), AW, TP, DM}; pg8::StaticOrder S; S.init(AW, TP, G, bid);
        EpiVT E{WSP(bf16_t, WS_VT), rep == 0 ? SMALLF(0) : SMALLF(5)};
        pg8::gemm_phase<EpiVT, pg8::StaticOrder, true, true>(lds, g, S, E);
    }
    for (int rep = 0; rep < REP1; ++rep) {
        PH_IDS; ArgP A = args_ptr(); unsigned char* ws = A->ws; float* UVGS = WSP(float, WS_UVGS);
        mini_gemm(WSP(bf16_t, WS_XN) + (size_t)TP * DM, WSP(bf16_t, WS_W1), DM, 6144, gw, NGW, lane, [=](int row, int n, f32x4 v) {
            int ty, ch; if (n < 2048) { ty = 1; ch = n; } else { const int t = (n - 2048) >> 8, w = (n - 2048) & 255; if (w < 128) { ty = 0; ch = 128 * t + w; } else { ty = 2; ch = 128 * t + w - 128; } }
            *(f32x4*)(UVGS + ((size_t)row * 3 + ty) * AW + ch) = v; });
    }

#ifdef XK
    for (int rep = 0; rep < XK; ++rep) {
        PH_IDS; ArgP A = args_ptr(); unsigned char* ws = A->ws;
        pg8::Gemm g{WSP(bf16_t, WS_W1), WSP(bf16_t, WS_XN), AW, TP, DM}; pg8::StaticOrder S; S.init(AW, TP, G, bid);
        EpiNull E{WSP(float, WS_DUMMY)};
        pg8::gemm_phase<EpiNull, pg8::StaticOrder, true, true>(lds, g, S, E);
    }
#endif
#ifdef XM
    for (int rep = 0; rep < XM; ++rep) {
        PH_IDS; ArgP A = args_ptr(); unsigned char* ws = A->ws; float* DUM = WSP(float, WS_DUMMY);
        mini_gemm(WSP(bf16_t, WS_XN) + (size_t)TP * DM, WSP(bf16_t, WS_W1), DM, 6144, gw, NGW, lane, [=](int row, int n, f32x4 v) {
            *(f32x4*)(DUM + ((size_t)row * 6144) + n) = v; });
    }
#endif
    GSYNC();

    for (int rep = 0; rep < REP2; ++rep) {
        PH_IDS; ArgP A = args_ptr(); unsigned char* ws = A->ws;
        pg8::Gemm g{WSP(bf16_t, WS_XN), WSP(bf16_t, WS_W1) + (size_t)2048 * DM, TP, 4096, DM}; pg8::StaticOrder S; S.init(TP, 4096, G, bid);
        EpiUG E{WSP(bf16_t, WS_VT), SMALLF(0), A->w_s_a, A->b_s_a, A->v_norm_a, WSP(bf16_t, WS_Y), lds + pg8::STAGE_BYTES + 16};
        pg8::gemm_phase<EpiUG, pg8::StaticOrder, true, true>(lds, g, S, E);
    }
    {
        PH_IDS; ArgP A = args_ptr(); unsigned char* ws = A->ws; const float* UVGS = WSP(float, WS_UVGS); bf16_t* Y = WSP(bf16_t, WS_Y);
        const float* v_norm = A->v_norm_a; const float* w_s = A->w_s_a; const float* b_s = A->b_s_a; float* out = A->out;
        for (int b = gw; b < TS; b += NGW) {
            const float* ur = UVGS + (size_t)b * 3 * AW; const float* vr = ur + AW; const float* gr = ur + 2 * AW;
            f32x4 vv[8]; float s = 0.f;
#pragma unroll
            for (int i = 0; i < 8; ++i) { vv[i] = *(const f32x4*)(vr + 4 * (lane + 64 * i)); s += (vv[i][0] * vv[i][0] + vv[i][1] * vv[i][1]) + (vv[i][2] * vv[i][2] + vv[i][3] * vv[i][3]); }
            const float rs = rsqrtf(wave_sum(s) * (1.0f / AW) + EPS);
#pragma unroll
            for (int i = 0; i < 8; ++i) {
                const int c = 4 * (lane + 64 * i), gi = c >> 8;
                const f32x4 gvv = *(const f32x4*)(v_norm + c), uu = *(const f32x4*)(ur + c), gg = *(const f32x4*)(gr + c);
                const float w00 = w_s[(size_t)gi * 128 * 128], b0 = b_s[gi * 128];
                f32x4 vn, y;
#pragma unroll
                for (int e = 0; e < 4; ++e) { vn[e] = vv[i][e] * rs * gvv[e]; y[e] = uu[e] * (w00 * vn[e] + b0) * silu(gg[e]); }
                *(f32x4*)(out + OUT_AV + (size_t)b * AW + c) = vn;
                u32x2 o; o.x = pk2(y[0], y[1]); o.y = pk2(y[2], y[3]);
                *(u32x2*)(Y + (size_t)(TP + b) * AW + c) = o;
            }
        }
    }
    GSYNC();

    for (int rep = 0; rep < REP3; ++rep) {
        PH_IDS; ArgP A = args_ptr(); unsigned char* ws = A->ws;
        pg8::Gemm g{WSP(bf16_t, WS_Y), WSP(bf16_t, WS_W2), TP, DM, AW}; pg8::StaticOrder S; S.init(TP, DM, G, bid);
        EpiRes<true> E{A->x_prompt, A->out, WSP(bf16_t, WS_XN), rep == 0 ? SMALLF(1) : SMALLF(5)};
        pg8::gemm_phase<EpiRes<true>, pg8::StaticOrder, true, true>(lds, g, S, E);
    }
    for (int rep = 0; rep < REP3; ++rep) {
        PH_IDS; ArgP A = args_ptr(); unsigned char* ws = A->ws; const float* xs = A->x_sample; float* H = A->out; bf16_t* H1b = WSP(bf16_t, WS_XN); float* hsq = rep == 0 ? SMALLF(1) : SMALLF(5);
        mini_gemm(WSP(bf16_t, WS_Y) + (size_t)TP * AW, WSP(bf16_t, WS_W2), AW, DM, gw, NGW, lane, [=](int row, int n, f32x4 v) {
            const f32x4 h = v + *(const f32x4*)(xs + (size_t)row * DM + n);
            *(f32x4*)(H + (size_t)(TP + row) * DM + n) = h;
            u32x2 o; o.x = pk2(h[0], h[1]); o.y = pk2(h[2], h[3]); *(u32x2*)(H1b + (size_t)(TP + row) * DM + n) = o;
            float s = (h[0] * h[0] + h[1] * h[1]) + (h[2] * h[2] + h[3] * h[3]); s += __shfl_xor(s, 16); s += __shfl_xor(s, 32);
            if ((threadIdx.x & 63) < 16) unsafeAtomicAdd(hsq + TP + row, s); });
    }
    GSYNC();

    for (int rep = 0; rep < REP4; ++rep) {
        PH_IDS; ArgP A = args_ptr(); unsigned char* ws = A->ws; float* out = A->out;
        pg8::Gemm g{WSP(bf16_t, WS_XN), WSP(bf16_t, WS_W3), TP, 2560, DM}; pg8::StaticOrder S; S.init(TP, 2560, G, bid);
        Epi3 E{SMALLF(1), SMALLF(3), WSP(bf16_t, WS_Y), WSP(bf16_t, WS_Y) + (size_t)TP * 256, WSP(bf16_t, WS_VT), WSP(bf16_t, WS_VT) + (size_t)TP * DM, out + OUT_KP, out + OUT_VP};
        pg8::gemm_phase<Epi3, pg8::StaticOrder, true, true>(lds, g, S, E);
    }
    for (int rep = 0; rep < REP4; ++rep) {
        PH_IDS; ArgP A = args_ptr(); unsigned char* ws = A->ws; float* KVQGS = WSP(float, WS_KVQGS); const float* hsq = SMALLF(1);
        mini_gemm(WSP(bf16_t, WS_XN) + (size_t)TP * DM, WSP(bf16_t, WS_W3), DM, 2560, gw, NGW, lane, [=](int row, int n, f32x4 v) {
            const float rs = rsqrtf(hsq[TP + row] * (1.0f / DM) + EPS);
            *(f32x4*)(KVQGS + (size_t)row * 2560 + n) = v * rs; });
    }
    GSYNC();

    for (int rep = 0; rep < REP5; ++rep) {
        PH_IDS; ArgP A = args_ptr(); unsigned char* ws = A->ws;
        attn_prompt(lds, WSP(bf16_t, WS_VT), WSP(bf16_t, WS_Y), WSP(bf16_t, WS_Y) + (size_t)TP * 256, WSP(bf16_t, WS_VT) + (size_t)TP * DM, A->sinks_b, WSP(bf16_t, WS_XN), G, bid, tid, wave, lane);
    }
    for (int rep = 0; rep < REP5; ++rep) {
        PH_IDS; ArgP A = args_ptr(); unsigned char* ws = A->ws;
        attn_sample(A->cache_k, A->cache_v, A->sinks_b, A->out, WSP(float, WS_KVQGS), SMALLF(3), WSP(bf16_t, WS_XN), gw, NGW, lane);
    }
    GSYNC();

    for (int rep = REP6 - 1; rep >= 0; --rep) {
        PH_IDS; ArgP A = args_ptr(); unsigned char* ws = A->ws; float* H = A->out;
        pg8::Gemm g{WSP(bf16_t, WS_XN), WSP(bf16_t, WS_W4), TP, DM, DM}; pg8::StaticOrder S; S.init(TP, DM, G, bid);
        EpiRes<false> E{H, rep == 0 ? H : WSP(float, WS_DUMMY), nullptr, rep == 0 ? SMALLF(2) : SMALLF(5)};
        pg8::gemm_phase<EpiRes<false>, pg8::StaticOrder, true, true>(lds, g, S, E);
    }
    {
        PH_IDS; ArgP A = args_ptr(); unsigned char* ws = A->ws; float* H = A->out; float* h2sq = SMALLF(2);
        mini_gemm(WSP(bf16_t, WS_XN) + (size_t)TP * DM, WSP(bf16_t, WS_W4), DM, DM, gw, NGW, lane, [=](int row, int n, f32x4 v) {
            float* hp = H + (size_t)(TP + row) * DM + n;
            const f32x4 h = v + *(const f32x4*)hp; *(f32x4*)hp = h;
            float s = (h[0] * h[0] + h[1] * h[1]) + (h[2] * h[2] + h[3] * h[3]); s += __shfl_xor(s, 16); s += __shfl_xor(s, 32);
            if ((threadIdx.x & 63) < 16) unsafeAtomicAdd(h2sq + TP + row, s); });
    }
    GSYNC();

    for (int rep = REP7 - 1; rep >= 0; --rep) {
        PH_IDS; ArgP A = args_ptr(); unsigned char* ws = A->ws; float* H = A->out; const float* h2sq = SMALLF(2); const float* fnp = A->final_norm; float* HO = rep == 0 ? H : WSP(float, WS_DUMMY);
        for (int row = gw; row < TT; row += NGW) {
            const float rs = rsqrtf(h2sq[row] * (1.0f / DM) + EPS);
            const float* hp = H + (size_t)row * DM; float* ho = HO + (size_t)row * DM;
#pragma unroll
            for (int j = 0; j < 4; ++j) { const int c = 4 * lane + 256 * j; const f32x4 h = *(const f32x4*)(hp + c), fn = *(const f32x4*)(fnp + c); *(f32x4*)(ho + c) = h * rs * fn; }
        }
    }
}

extern "C" void kernel_launch(void* const* d_in, const int* in_sizes, int n_in, void* d_out, int out_size, void* d_ws, size_t ws_size, hipStream_t stream) {
    constexpr int LDS_BYTES = pg8::STAGE_BYTES + 16 + WSL_BYTES;
    static int grid_blocks = 0;
    if (grid_blocks == 0) {
        if (n_in != 17 || ws_size < WS_END) { fprintf(stderr, "kernel_launch: unexpected inputs (n_in %d, ws %zu)\n", n_in, ws_size); grid_blocks = -1; return; }
        int dev = 0, cus = 0, per_cu = 0;
        hipGetDevice(&dev); hipDeviceGetAttribute(&cus, hipDeviceAttributeMultiprocessorCount, dev);
        if (hipFuncSetAttribute((const void*)yoco_fwd, hipFuncAttributeMaxDynamicSharedMemorySize, LDS_BYTES) != hipSuccess) { fprintf(stderr, "kernel_launch: hipFuncSetAttribute failed\n"); grid_blocks = -1; return; }
        if (hipOccupancyMaxActiveBlocksPerMultiprocessor(&per_cu, (const void*)yoco_fwd, 512, LDS_BYTES) != hipSuccess || per_cu < 1) { fprintf(stderr, "kernel_launch: occupancy query says %d blocks per CU\n", per_cu); per_cu = 1; }
        (void)hipGetLastError();
        grid_blocks = cus;
    }
    if (grid_blocks < 0) return;
    Params p{};
    p.x_prompt = (const float*)d_in[0]; p.x_sample = (const float*)d_in[1]; p.cache_k = (const float*)d_in[2]; p.cache_v = (const float*)d_in[3];
    p.norm_a = (const float*)d_in[4]; p.w_in_a = (const float*)d_in[5]; p.v_norm_a = (const float*)d_in[6]; p.w_s_a = (const float*)d_in[7]; p.b_s_a = (const float*)d_in[8];
    p.w_out_a = (const float*)d_in[9]; p.kv_norm = (const float*)d_in[10]; p.w_kv = (const float*)d_in[11]; p.norm_b = (const float*)d_in[12]; p.w_in_b = (const float*)d_in[13];
    p.sinks_b = (const float*)d_in[14]; p.w_out_b = (const float*)d_in[15]; p.final_norm = (const float*)d_in[16];
    p.out = (float*)d_out; p.ws = (unsigned char*)d_ws;
    if (hipMemsetAsync((unsigned char*)d_ws + WS_SMALL + (size_t)BAR_F32_IDX * 4, 0, XCD_BAR_WORDS * 4, stream) != hipSuccess) { fprintf(stderr, "kernel_launch: memset of the barrier words failed\n"); return; }
    void* args[] = {&p};
    hipError_t e = hipLaunchCooperativeKernel((const void*)yoco_fwd, dim3(grid_blocks), dim3(512), args, LDS_BYTES, stream);
    if (e != hipSuccess) fprintf(stderr, "kernel_launch: cooperative launch failed: %s (grid %d)\n", hipGetErrorString(e), grid_blocks);
}
```
